# Optimizing an MI355X kernel written in HIP

```python
import math
import jax
import jax.numpy as jnp
from jax import lax
import numpy as np

D_MODEL = 1024
BATCH = 16
SEQ = 4096
DEPTH = 1

GRID_W = 64
CTX_LEN = 256

ATTN_HEADS = 4
ATTN_HEAD_DIM = 64
ATTN_QK_WIDTH = ATTN_HEADS * 2 * ATTN_HEAD_DIM
ATTN_V_WIDTH = ATTN_HEADS * 2 * ATTN_HEAD_DIM
Q_BLOCK = 128
ROPE_BASE = 10000.0

SSM_WIDTH = D_MODEL - ATTN_V_WIDTH
SSM_GROUP = 16
SSM_GROUPS = SSM_WIDTH // SSM_GROUP
SSM_STATE = 64
DT_MIN = 1e-3
DT_MAX = 1e-1

IN_PROJ_WIDTH = 2 * ATTN_QK_WIDTH + ATTN_V_WIDTH + SSM_WIDTH

MOE_GROUPS = 4
EXPERTS_PER_GROUP = 8
N_EXPERTS = MOE_GROUPS * EXPERTS_PER_GROUP
TOP_K_IN_GROUP = 2
EXPERT_FF = D_MODEL // 2

RMS_EPS = 1e-6

kernel_name = 'hybrid_diffattn_s5_hmoe_dit_block'


def rms_norm(x, g):
    xf = x.astype(jnp.float32)
    y = xf * lax.rsqrt(jnp.mean(xf * xf, axis=-1, keepdims=True) + RMS_EPS)
    return (y * g.astype(jnp.float32)).astype(x.dtype)


def modulate(h, shift, scale):
    return h * (1.0 + scale) + shift


def axial_rope_tables(n_tokens):
    rows = n_tokens // GRID_W
    row = jnp.broadcast_to(jnp.arange(rows, dtype=jnp.float32)[:, None], (rows, GRID_W)).reshape(-1)
    col = jnp.broadcast_to(jnp.arange(GRID_W, dtype=jnp.float32)[None, :], (rows, GRID_W)).reshape(-1)
    half = ATTN_HEAD_DIM // 2
    inv = ROPE_BASE ** (-jnp.arange(0, half, 2, dtype=jnp.float32) / half)
    ang = jnp.stack([row[:, None] * inv, col[:, None] * inv], axis=1)
    return jnp.cos(ang), jnp.sin(ang)


def apply_axial_rope(x, cos, sin):
    xr = x.astype(jnp.float32).reshape(*x.shape[:-1], 2, 2, ATTN_HEAD_DIM // 4)
    x1, x2 = xr[..., 0, :], xr[..., 1, :]
    cs = cos[None, :, None, None]
    sn = sin[None, :, None, None]
    out = jnp.stack([x1 * cs - x2 * sn, x2 * cs + x1 * sn], axis=-2)
    return out.reshape(x.shape).astype(x.dtype)


def split_in_proj(p):
    b, n, _ = p.shape
    q = p[..., :ATTN_QK_WIDTH].reshape(b, n, ATTN_HEADS, 2, ATTN_HEAD_DIM)
    k = p[..., ATTN_QK_WIDTH:2 * ATTN_QK_WIDTH].reshape(b, n, ATTN_HEADS, 2, ATTN_HEAD_DIM)
    v = p[..., 2 * ATTN_QK_WIDTH:2 * ATTN_QK_WIDTH + ATTN_V_WIDTH].reshape(b, n, ATTN_HEADS, 2 * ATTN_HEAD_DIM)
    u = p[..., 2 * ATTN_QK_WIDTH + ATTN_V_WIDTH:]
    return q, k, v, u


def diff_lambda(lq1, lk1, lq2, lk2, lam_init):
    e1 = jnp.exp(jnp.sum(lq1.astype(jnp.float32) * lk1.astype(jnp.float32)))
    e2 = jnp.exp(jnp.sum(lq2.astype(jnp.float32) * lk2.astype(jnp.float32)))
    return e1 - e2 + lam_init


def diff_softmax_attend(q, k, v, lam):
    s = jnp.einsum('bqhcd,bkhcd->bhcqk', q, k, preferred_element_type=jnp.float32) * (ATTN_HEAD_DIM ** -0.5)
    p = jax.nn.softmax(s, axis=-1)
    a = p[:, :, 0] - lam * p[:, :, 1]
    return jnp.einsum('bhqk,bkhe->bqhe', a.astype(v.dtype), v)


def diff_attention_latent(q, k_lat, v_lat, k_ctx, v_ctx, lam):
    b, n = q.shape[:2]
    k_all = jnp.concatenate([k_lat, k_ctx], axis=1)
    v_all = jnp.concatenate([v_lat, v_ctx], axis=1)
    nblk = n // Q_BLOCK
    qb = q.reshape(b, nblk, Q_BLOCK, *q.shape[2:]).swapaxes(0, 1)
    ob = lax.map(lambda qi: diff_softmax_attend(qi, k_all, v_all, lam), qb)
    return ob.swapaxes(0, 1).reshape(b, n, ATTN_HEADS, 2 * ATTN_HEAD_DIM)


def diff_head_out(o, subln_g, lam_init):
    o = rms_norm(o, subln_g) * (1.0 - lam_init)
    return o.reshape(*o.shape[:2], ATTN_V_WIDTH)


def cplx_mul(ar, ai, br, bi):
    return ar * br - ai * bi, ar * bi + ai * br


def s5_combine(e_i, e_j):
    a_r, a_i, b_r, b_i = e_i
    c_r, c_i, d_r, d_i = e_j
    ar, ai = cplx_mul(c_r, c_i, a_r, a_i)
    br, bi = cplx_mul(c_r, c_i, b_r, b_i)
    return ar, ai, br + d_r, bi + d_i


def s5_discretise(a_re, a_im, log_dt, b_re, b_im):
    dt = jnp.exp(log_dt.astype(jnp.float32))[:, None]
    ar, ai = a_re.astype(jnp.float32), a_im.astype(jnp.float32)
    mag = jnp.exp(ar * dt)
    lr, li = mag * jnp.cos(ai * dt), mag * jnp.sin(ai * dt)
    den = ar * ar + ai * ai
    nr, ni = lr - 1.0, li
    cr = (nr * ar + ni * ai) / den
    ci = (ni * ar - nr * ai) / den
    bbr, bbi = cplx_mul(cr[..., None], ci[..., None], b_re.astype(jnp.float32), b_im.astype(jnp.float32))
    return lr, li, bbr, bbi


def s5_scan(u, lam_r, lam_i, bb_r, bb_i, h0):
    bu_r = jnp.einsum('gph,bngh->bngp', bb_r, u)
    bu_i = jnp.einsum('gph,bngh->bngp', bb_i, u)
    if h0 is not None:
        ir, ii = cplx_mul(lam_r, lam_i, h0[0], h0[1])
        bu_r = bu_r.at[:, 0].add(ir)
        bu_i = bu_i.at[:, 0].add(ii)
    n = u.shape[1]
    a_r = jnp.broadcast_to(lam_r, (1, n) + lam_r.shape)
    a_i = jnp.broadcast_to(lam_i, (1, n) + lam_i.shape)
    _, _, h_r, h_i = lax.associative_scan(s5_combine, (a_r, a_i, bu_r, bu_i), axis=1)
    return h_r, h_i


def s5_readout(c_re, c_im, h_r, h_i):
    return jnp.einsum('ghp,bngp->bngh', c_re, h_r) - jnp.einsum('ghp,bngp->bngh', c_im, h_i)


def s5_glu(y, w_glu, b_glu, dtype):
    y = jax.nn.gelu(y.reshape(*y.shape[:2], SSM_WIDTH)).astype(dtype)
    return y * jax.nn.sigmoid(y @ w_glu + b_glu)


def s5_mixer(u_lat, u_ctx, a_re, a_im, log_dt, b_re, b_im, c_re, c_im, d_skip, w_glu, b_glu, need_ctx):
    b, n, _ = u_lat.shape
    nc = u_ctx.shape[1]
    ul = u_lat.astype(jnp.float32).reshape(b, n, SSM_GROUPS, SSM_GROUP)
    uc = u_ctx.astype(jnp.float32).reshape(b, nc, SSM_GROUPS, SSM_GROUP)
    cr, ci = c_re.astype(jnp.float32), c_im.astype(jnp.float32)
    dd = d_skip.astype(jnp.float32)
    y_lat = dd * ul
    y_ctx = dd * uc if need_ctx else None
    for direction in range(2):
        lr, li, bbr, bbi = s5_discretise(a_re[direction], a_im[direction], log_dt[direction],
                                         b_re[direction], b_im[direction])
        ul_d = ul if direction == 0 else ul[:, ::-1]
        uc_d = uc if direction == 0 else uc[:, ::-1]
        hc_r, hc_i = s5_scan(uc_d, lr, li, bbr, bbi, None)
        hl_r, hl_i = s5_scan(ul_d, lr, li, bbr, bbi, (hc_r[:, -1], hc_i[:, -1]))
        yl = s5_readout(cr, ci, hl_r, hl_i)
        y_lat = y_lat + (yl if direction == 0 else yl[:, ::-1])
        if need_ctx:
            yc = s5_readout(cr, ci, hc_r, hc_i)
            y_ctx = y_ctx + (yc if direction == 0 else yc[:, ::-1])
    out_lat = s5_glu(y_lat, w_glu, b_glu, u_lat.dtype)
    out_ctx = s5_glu(y_ctx, w_glu, b_glu, u_ctx.dtype) if need_ctx else None
    return out_lat, out_ctx


def hier_moe(h, w_rg, b_rg, w_re, b_re, w_g, w_u, w_d):
    b, n, d = h.shape
    t = h.reshape(b * n, d)
    g_prob = jax.nn.softmax((t @ w_rg + b_rg).astype(jnp.float32), axis=-1)
    p_grp, g_idx = lax.top_k(g_prob, 1)
    e_logit = (t @ w_re + b_re).astype(jnp.float32).reshape(-1, MOE_GROUPS, EXPERTS_PER_GROUP)
    e_logit = jnp.take_along_axis(e_logit, g_idx[:, :, None], axis=1)[:, 0]
    top_v, top_i = lax.top_k(e_logit, TOP_K_IN_GROUP)
    w_slot = jax.nn.softmax(top_v, axis=-1) * p_grp
    e_id = g_idx * EXPERTS_PER_GROUP + top_i
    gates = jnp.einsum('tk,tke->te', w_slot,
                       jax.nn.one_hot(e_id, N_EXPERTS, dtype=jnp.float32)).astype(t.dtype)
    out = jnp.zeros_like(t)
    for e in range(N_EXPERTS):
        hid = jax.nn.silu(t @ w_g[e]) * (t @ w_u[e])
        out = out + gates[:, e:e + 1] * (hid @ w_d[e])
    return out.reshape(b, n, d)


def setup_inputs(seed: int = 0) -> dict:
    key = jax.random.key(seed)
    k = jax.random.split(key, 34)

    def nrm(i, shape, scale):
        return scale * jax.random.normal(k[i], shape, jnp.float32)

    D, F = D_MODEL, EXPERT_FF
    G, P, HS = SSM_GROUPS, SSM_STATE, SSM_GROUP
    d = ATTN_HEAD_DIM
    n_idx = jnp.arange(P, dtype=jnp.float32)
    return {
        'x': nrm(0, (BATCH, SEQ, D), 1.0),
        'c': nrm(1, (BATCH, D), 1.0),
        'ctx': nrm(2, (BATCH, CTX_LEN, D), 1.0),
        'c_ctx': nrm(3, (D,), 1.0),
        'w_ada': nrm(4, (DEPTH, D, 6 * D), 0.5 * D ** -0.5),
        'b_ada': nrm(5, (DEPTH, 6 * D), 0.01),
        'norm1_g': 1.0 + nrm(6, (DEPTH, D), 0.02),
        'w_in': nrm(7, (DEPTH, D, IN_PROJ_WIDTH), D ** -0.5),
        'q_norm_g': 1.0 + nrm(8, (DEPTH, d), 0.02),
        'k_norm_g': 1.0 + nrm(9, (DEPTH, d), 0.02),
        'lambda_q1': nrm(10, (DEPTH, d), 0.1),
        'lambda_k1': nrm(11, (DEPTH, d), 0.1),
        'lambda_q2': nrm(12, (DEPTH, d), 0.1),
        'lambda_k2': nrm(13, (DEPTH, d), 0.1),
        'subln_g': 1.0 + nrm(14, (DEPTH, 2 * d), 0.02),
        'ssm_a_re': -0.5 + nrm(15, (DEPTH, 2, G, P), 0.01),
        'ssm_a_im': math.pi * n_idx * (1.0 + nrm(16, (DEPTH, 2, G, P), 0.01)),
        'ssm_log_dt': jax.random.uniform(k[17], (DEPTH, 2, G), jnp.float32, math.log(DT_MIN), math.log(DT_MAX)),
        'ssm_b_re': nrm(18, (DEPTH, 2, G, P, HS), (2 * HS) ** -0.5),
        'ssm_b_im': nrm(19, (DEPTH, 2, G, P, HS), (2 * HS) ** -0.5),
        'ssm_c_re': nrm(20, (DEPTH, G, HS, P), P ** -0.5),
        'ssm_c_im': nrm(21, (DEPTH, G, HS, P), P ** -0.5),
        'ssm_d': nrm(22, (DEPTH, G, HS), 1.0),
        'w_glu': nrm(23, (DEPTH, SSM_WIDTH, SSM_WIDTH), SSM_WIDTH ** -0.5),
        'b_glu': nrm(24, (DEPTH, SSM_WIDTH), 0.01),
        'w_out': nrm(25, (DEPTH, D, D), D ** -0.5),
        'norm2_g': 1.0 + nrm(26, (DEPTH, D), 0.02),
        'w_route_group': nrm(27, (DEPTH, D, MOE_GROUPS), D ** -0.5),
        'b_route_group': nrm(28, (DEPTH, MOE_GROUPS), 0.01),
        'w_route_expert': nrm(29, (DEPTH, D, N_EXPERTS), D ** -0.5),
        'b_route_expert': nrm(30, (DEPTH, N_EXPERTS), 0.01),
        'w_exp_gate': nrm(31, (DEPTH, N_EXPERTS, D, F), D ** -0.5),
        'w_exp_up': nrm(32, (DEPTH, N_EXPERTS, D, F), D ** -0.5),
        'w_exp_down': nrm(33, (DEPTH, N_EXPERTS, F, D), F ** -0.5),
    }


def reference(x, c, ctx, c_ctx, w_ada, b_ada, norm1_g, w_in, q_norm_g, k_norm_g,
              lambda_q1, lambda_k1, lambda_q2, lambda_k2, subln_g,
              ssm_a_re, ssm_a_im, ssm_log_dt, ssm_b_re, ssm_b_im, ssm_c_re, ssm_c_im, ssm_d,
              w_glu, b_glu, w_out, norm2_g,
              w_route_group, b_route_group, w_route_expert, b_route_expert,
              w_exp_gate, w_exp_up, w_exp_down):
    n_lat = x.shape[1]
    cos, sin = axial_rope_tables(n_lat)
    h_ctx = ctx
    for l in range(DEPTH):
        last = l == DEPTH - 1
        lam_init = 0.8 - 0.6 * math.exp(-0.3 * l)
        mod = jax.nn.silu(c) @ w_ada[l] + b_ada[l]
        mod_c = jax.nn.silu(c_ctx) @ w_ada[l] + b_ada[l]
        sh1, sc1, g1, sh2, sc2, g2 = jnp.split(mod[:, None, :], 6, axis=-1)
        csh1, csc1, cg1, csh2, csc2, cg2 = jnp.split(mod_c, 6, axis=-1)

        px = modulate(rms_norm(x, norm1_g[l]), sh1, sc1) @ w_in[l]
        pc = modulate(rms_norm(h_ctx, norm1_g[l]), csh1, csc1) @ w_in[l]
        q_x, k_x, v_x, u_x = split_in_proj(px)
        q_c, k_c, v_c, u_c = split_in_proj(pc)
        q_x = apply_axial_rope(rms_norm(q_x, q_norm_g[l]), cos, sin)
        k_x = apply_axial_rope(rms_norm(k_x, k_norm_g[l]), cos, sin)
        k_c = rms_norm(k_c, k_norm_g[l])
        lam = diff_lambda(lambda_q1[l], lambda_k1[l], lambda_q2[l], lambda_k2[l], lam_init)
        a_x = diff_head_out(diff_attention_latent(q_x, k_x, v_x, k_c, v_c, lam), subln_g[l], lam_init)
        s_x, s_c = s5_mixer(u_x, u_c, ssm_a_re[l], ssm_a_im[l], ssm_log_dt[l], ssm_b_re[l], ssm_b_im[l],
                            ssm_c_re[l], ssm_c_im[l], ssm_d[l], w_glu[l], b_glu[l], not last)
        x = x + g1 * (jnp.concatenate([a_x, s_x], axis=-1) @ w_out[l])
        if not last:
            q_c = rms_norm(q_c, q_norm_g[l])
            a_c = diff_head_out(diff_softmax_attend(q_c, k_c, v_c, lam), subln_g[l], lam_init)
            h_ctx = h_ctx + cg1 * (jnp.concatenate([a_c, s_c], axis=-1) @ w_out[l])

        x = x + g2 * hier_moe(modulate(rms_norm(x, norm2_g[l]), sh2, sc2),
                              w_route_group[l], b_route_group[l], w_route_expert[l], b_route_expert[l],
                              w_exp_gate[l], w_exp_up[l], w_exp_down[l])
        if not last:
            h_ctx = h_ctx + cg2 * hier_moe(modulate(rms_norm(h_ctx, norm2_g[l]), csh2, csc2),
                                           w_route_group[l], b_route_group[l], w_route_expert[l],
                                           b_route_expert[l], w_exp_gate[l], w_exp_up[l], w_exp_down[l])
    return x
```

```cpp
#include <hip/hip_runtime.h>
#include <cstdio>
#include <cstdint>

#ifndef MK_ONE_LAUNCH
#define MK_ONE_LAUNCH 1
#endif

#define LAS __attribute__((address_space(3)))
#define GAS __attribute__((address_space(1)))
typedef unsigned short bf16_t;
typedef short bf16x8 __attribute__((ext_vector_type(8)));
typedef float f32x2 __attribute__((ext_vector_type(2)));
typedef float f32x4 __attribute__((ext_vector_type(4)));
typedef float f32x16 __attribute__((ext_vector_type(16)));
typedef unsigned u32x2 __attribute__((ext_vector_type(2)));
typedef unsigned u32x4 __attribute__((ext_vector_type(4)));

constexpr int T = 65536, TC = 4096, MT = T + TC, DM = 1024, NB = 16, SEQ = 4096, CTX = 256, KV = SEQ + CTX;
constexpr int NE = 32, FF = 512;
constexpr int SG = 32, SL = 32, A2_ROWS = 2304, A2_LD = 768, A2_LAT = 2048;
constexpr float RMS_EPS = 1e-6f;
constexpr float LAM_INIT = 0.2f;
constexpr float C2 = 0.125f * 1.4426950408889634f;
constexpr int LISTCAP = 65536;

constexpr size_t MiB = 1u << 20;
constexpr size_t WS_CTL = 0, CTL_ZERO_BYTES = 1 * MiB;
constexpr size_t WS_MOD = 1 * MiB;
constexpr size_t WS_MISC = 2 * MiB;
constexpr size_t WS_WQKU = 3 * MiB;
constexpr size_t WS_WV = 6 * MiB;
constexpr size_t WS_WGLU = 7 * MiB;
constexpr size_t WS_WR = 7 * MiB + 512 * 1024;
constexpr size_t WS_WOUT = 8 * MiB;
constexpr size_t WS_S5W1 = 10 * MiB;
constexpr size_t WS_S5W2 = 18 * MiB;
constexpr size_t WS_WGU = 42 * MiB;
constexpr size_t WS_WD = 106 * MiB;
constexpr size_t WS_LTOK = 138 * MiB;
constexpr size_t WS_LW = 154 * MiB;
constexpr size_t WS_XN = 170 * MiB;
constexpr size_t WS_A28 = 240 * MiB;
constexpr size_t WS_Q = 306 * MiB;
constexpr size_t WS_K = 370 * MiB;
constexpr size_t WS_VT = 438 * MiB;
constexpr size_t WS_H = 306 * MiB;
constexpr size_t WS_A2 = 506 * MiB;
constexpr size_t WS_SB = 614 * MiB;
constexpr size_t WS_YG = 686 * MiB;
constexpr size_t WS_AO = 750 * MiB;
constexpr size_t WS_X1B = 506 * MiB;
constexpr size_t WS_T8 = 170 * MiB;
constexpr size_t WS_LROW = 880 * MiB;
constexpr size_t WS_PTOK = 896 * MiB;
constexpr size_t WS_TRASH = 1008 * MiB;
constexpr size_t WS_END = 1009 * MiB;

constexpr int CW_TMO = 0;
constexpr int CW_BAR = 4096;
constexpr int CW_CNT = 16384;
constexpr int CW_CNT2 = 16384 + 64;
constexpr int NPAIR = 112;

constexpr int RING_BYTES = 131072;
constexpr int LDSCTL_OFF = RING_BYTES, MISC_OFF = LDSCTL_OFF + 1024;
constexpr int LDS_BYTES = 147456;

#define RLX_AGENT __ATOMIC_RELAXED, __HIP_MEMORY_SCOPE_AGENT

__device__ __forceinline__ unsigned cvt_pk_bf16(float lo, float hi) { unsigned r; asm volatile("v_cvt_pk_bf16_f32 %0, %1, %2" : "=v"(r) : "v"(lo), "v"(hi)); return r; }
__device__ __forceinline__ float bf_lo(unsigned u) { return __builtin_bit_cast(float, u << 16); }
__device__ __forceinline__ float bf_hi(unsigned u) { return __builtin_bit_cast(float, u & 0xffff0000u); }
__device__ __forceinline__ u32x2 pack8_fp8(float a0, float a1, float a2, float a3, float a4, float a5, float a6, float a7) { int w0 = 0, w1 = 0;
    w0 = __builtin_amdgcn_cvt_pk_fp8_f32(a0, a1, w0, false); w0 = __builtin_amdgcn_cvt_pk_fp8_f32(a2, a3, w0, true); w1 = __builtin_amdgcn_cvt_pk_fp8_f32(a4, a5, w1, false); w1 = __builtin_amdgcn_cvt_pk_fp8_f32(a6, a7, w1, true);
    u32x2 o; o.x = (unsigned)w0; o.y = (unsigned)w1; return o; }
__device__ __forceinline__ float wave_sum(float v) {
#pragma unroll
    for (int o = 1; o < 64; o <<= 1) v += __shfl_xor(v, o);
    return v;
}
__device__ __forceinline__ float fast_rcp(float x) { return __builtin_amdgcn_rcpf(x); }
__device__ __forceinline__ float sigmoidf_(float x) { return fast_rcp(1.f + __builtin_amdgcn_exp2f(-1.4426950408889634f * x)); }

namespace pg8 {
constexpr int BM = 256, BK = 64, HALF = 128, HTB = HALF * BK * 2, STAGE_BYTES = 8 * HTB;
__host__ __device__ __forceinline__ int lds_byte(int r, int c) { const int st = (r >> 4) * 2 + (c >> 5), rr = r & 15, cc = c & 31, ob = rr * 64 + cc * 2; return st * 1024 + (ob ^ (((ob >> 9) & 1) << 5)); }
__host__ __device__ __forceinline__ void stage_rc(int b, int& R, int& C) { const int st = b / 1024, sb = b % 1024, swz = sb ^ (((sb >> 9) & 1) << 5); R = (st >> 1) * 16 + swz / 64; C = (st & 1) * 32 + (swz % 64) / 2; }
__host__ __device__ __forceinline__ int perm32(int rho) { const int n = rho >> 4, i = rho & 15; return 8 * (i >> 2) + 4 * n + (i & 3); }

struct Unit { int pm, pn, grp, aux, half; };
struct Gemm { int lda, ldb, K; };

typedef int v8i_t __attribute__((ext_vector_type(8)));
typedef int v4i_t __attribute__((ext_vector_type(4)));
template <class Epi, class Sched, bool ALIGN_EPI, bool FP8 = false, bool STACKB = false>
__device__ __forceinline__ void gemm_phase(LAS unsigned char* lds, const Gemm g, const Sched& S, const Epi& E) {
    const int tid = threadIdx.x, wid = __builtin_amdgcn_readfirstlane(tid >> 6), lane = tid & 63, wr = wid >> 2, wc = wid & 3, fr = lane & 15, fq = lane >> 4;
    const int K = g.K, nt = K / BK;
    int RR[2], CC[2]; unsigned voffB[2];
#pragma unroll
    for (int i = 0; i < 2; ++i) { stage_rc(tid * 16 + i * 8192, RR[i], CC[i]); const int Rb = Epi::PERM ? ((RR[i] & ~31) + perm32(RR[i] & 31)) : RR[i];
        voffB[i] = (unsigned)(Rb * g.ldb + CC[i]) * 2u; }
    const size_t kstep = (size_t)(BK * 2);
    const size_t hstepB = (size_t)HALF * g.ldb * 2;
    const unsigned ldsw = (unsigned)wid * 1024u;
    const int aoff = FP8 ? lds_byte(wr * 64 + fr, (fq >> 1) * 32 + (fq & 1) * 16) : lds_byte(wr * 64 + fr, fq * 8), boff = FP8 ? lds_byte(wc * 32 + fr, (fq >> 1) * 32 + (fq & 1) * 16) : lds_byte(wc * 32 + fr, fq * 8);
#define PG8_SA(b, h) (((b) * 2 + (h)) * HTB)
#define PG8_SB(b, h) ((4 + (b) * 2 + (h)) * HTB)
#define PG8_STAGE_B(bufoff, gbase) do { _Pragma("unroll") for (int _i = 0; _i < 2; ++_i) \
        __builtin_amdgcn_global_load_lds((const unsigned*)((const char*)(gbase) + voffB[_i]), (LAS unsigned*)(lds + (bufoff) + ldsw + _i * 8192), 16, 0, 0); } while (0)
#define PG8_STAGE_A(bufoff, gbase, V0, V1) do { \
        __builtin_amdgcn_global_load_lds((const unsigned*)((const char*)(gbase) + (V0)), (LAS unsigned*)(lds + (bufoff) + ldsw), 16, 0, 0); \
        __builtin_amdgcn_global_load_lds((const unsigned*)((const char*)(gbase) + (V1)), (LAS unsigned*)(lds + (bufoff) + ldsw + 8192), 16, 0, 0); } while (0)
#define PG8_LDA(dst, b, h) do { if constexpr (FP8) { _Pragma("unroll") for (int m = 0; m < 4; ++m) { dst##8[m].lo = *(const LAS v4i_t*)(lds + PG8_SA(b, h) + aoff + m * 2048); dst##8[m].hi = *(const LAS v4i_t*)(lds + PG8_SA(b, h) + aoff + m * 2048 + 16); } } \
        else { _Pragma("unroll") for (int m = 0; m < 4; ++m) _Pragma("unroll") for (int k = 0; k < 2; ++k) dst[m][k] = *(const LAS bf16x8*)(lds + PG8_SA(b, h) + aoff + m * 2048 + k * 1024); } } while (0)
#define PG8_LDB(dst, b, h) do { if constexpr (FP8) { _Pragma("unroll") for (int n = 0; n < 2; ++n) { dst##8[n].lo = *(const LAS v4i_t*)(lds + PG8_SB(b, h) + boff + n * 2048); dst##8[n].hi = *(const LAS v4i_t*)(lds + PG8_SB(b, h) + boff + n * 2048 + 16); } } \
        else { _Pragma("unroll") for (int n = 0; n < 2; ++n) _Pragma("unroll") for (int k = 0; k < 2; ++k) dst[n][k] = *(const LAS bf16x8*)(lds + PG8_SB(b, h) + boff + n * 2048 + k * 1024); } } while (0)
#define PG8_MMA(ai, bj, At, Bt) do { __builtin_amdgcn_s_setprio(1); \
        if constexpr (FP8) { _Pragma("unroll") for (int m = 0; m < 4; ++m) _Pragma("unroll") for (int n = 0; n < 2; ++n) \
            asm volatile("v_mfma_scale_f32_16x16x128_f8f6f4 %0, %1, %2, %0, %3, %4 op_sel_hi:[0,0,0]" : "+v"(acc[ai][bj][m][n]) : "v"(Bt##8[n]), "v"(At##8[m]), "v"(f8scale), "v"(f8scale2)); } \
              \
        else { _Pragma("unroll") for (int m = 0; m < 4; ++m) _Pragma("unroll") for (int n = 0; n < 2; ++n) _Pragma("unroll") for (int k = 0; k < 2; ++k) \
            acc[ai][bj][m][n] = __builtin_amdgcn_mfma_f32_16x16x32_bf16(Bt[n][k], At[m][k], acc[ai][bj][m][n], 0, 0, 0); } \
        __builtin_amdgcn_s_setprio(0); } while (0)
#define PG8_WAIT_V(n) asm volatile("s_waitcnt vmcnt(" #n ")" ::: "memory")
#define PG8_WAIT_V8R(relax) do { if (relax) asm volatile("s_waitcnt vmcnt(%0)" :: "n"(8 + Epi::NST) : "memory"); else asm volatile("s_waitcnt vmcnt(8)" ::: "memory"); } while (0)
#define PG8_WAIT_L(n) asm volatile("s_waitcnt lgkmcnt(" #n ")" ::: "memory")
#define PG8_BAR __builtin_amdgcn_s_barrier()
#define PG8_SCHED __builtin_amdgcn_sched_barrier(0)
#define PG8_MKVO(u, v00, v01, v10, v11) do { \
        v00 = (S.arow(u, RR[0]) * (unsigned)g.lda + (unsigned)CC[0]) * 2u; v01 = (S.arow(u, RR[1]) * (unsigned)g.lda + (unsigned)CC[1]) * 2u; \
        v10 = (S.arow(u, HALF + RR[0]) * (unsigned)g.lda + (unsigned)CC[0]) * 2u; v11 = (S.arow(u, HALF + RR[1]) * (unsigned)g.lda + (unsigned)CC[1]) * 2u; } while (0)
    Unit cur, nxt; int ui = 0;
    cur.half = 0; nxt.half = 0;
    if (!S.next(0, cur)) return;
    f32x4 acc[2][2][4][2];
#pragma unroll
    for (int a = 0; a < 2; ++a)
#pragma unroll
        for (int b = 0; b < 2; ++b)
#pragma unroll
            for (int m = 0; m < 4; ++m)
#pragma unroll
                for (int n = 0; n < 2; ++n) acc[a][b][m][n] = (f32x4){0.f, 0.f, 0.f, 0.f};
    bf16x8 At[4][2], B0[2][2], B1[2][2]; v8i_t At8[4], B08[2], B18[2];
    int f8scale = 0x7f7f7f7f, f8scale2 = Epi::F8SC; asm volatile("" : "+v"(f8scale), "+v"(f8scale2));
    unsigned c00, c01, c10, c11, n00, n01, n10, n11;
    PG8_MKVO(cur, c00, c01, c10, c11);
    const char* cA = S.abase(cur); const char* cB = S.bbase(cur); const char* cB2 = cB; if constexpr (STACKB) cB2 = S.bbase2(cur);
    PG8_STAGE_B(PG8_SB(0, 0), cB); PG8_STAGE_B(PG8_SB(0, 1), cB + hstepB); PG8_STAGE_A(PG8_SA(0, 0), cA, c00, c01); PG8_STAGE_A(PG8_SA(0, 1), cA, c10, c11);
    if (wr == 1) PG8_BAR;
    PG8_WAIT_V(2); PG8_BAR;
    PG8_STAGE_B(PG8_SB(1, 0), cB + kstep); PG8_STAGE_A(PG8_SA(1, 0), cA + kstep, c00, c01); PG8_STAGE_B(PG8_SB(1, 1), cB + hstepB + kstep);
    PG8_WAIT_V(6); PG8_BAR;
    for (;;) {
        nxt.half = 0; const bool has_next = S.next(ui + 1, nxt);
        const char* nA = cA; const char* nB = cB; n00 = c00; n01 = c01; n10 = c10; n11 = c11;
        const char* nB2 = cB2;
        if (has_next) { nA = S.abase(nxt); nB = S.bbase(nxt); if constexpr (STACKB) nB2 = S.bbase2(nxt); PG8_MKVO(nxt, n00, n01, n10, n11); }
#pragma unroll 1
        for (int t = 0; t < nt; t += 2) {
            const bool last = (t == nt - 2);
            const char* a1 = cA + (size_t)(t + 1) * kstep;
            const char* a2 = last ? nA : cA + (size_t)(t + 2) * kstep;
            const char* b2 = last ? nB : ((STACKB && t + 2 >= nt / 2) ? cB2 + (size_t)(t + 2 - nt / 2) * kstep : cB + (size_t)(t + 2) * kstep);
            const char* a3 = a2 + kstep; const char* b3 = b2 + kstep;
            const unsigned x00 = last ? n00 : c00, x01 = last ? n01 : c01, x10 = last ? n10 : c10, x11 = last ? n11 : c11;
            const bool relax = (Epi::NST > 0) && (t == 0) && (ui > 0);
            PG8_LDB(B0, 0, 0); PG8_LDB(B1, 0, 1); PG8_SCHED; PG8_LDA(At, 0, 0); PG8_STAGE_A(PG8_SA(1, 1), a1, c10, c11);
            PG8_WAIT_V8R(relax); PG8_WAIT_L(0); PG8_BAR; PG8_MMA(0, 0, At, B0); PG8_MMA(0, 1, At, B1); PG8_BAR; PG8_SCHED;
            PG8_LDA(At, 0, 1); PG8_STAGE_B(PG8_SB(0, 0), b2); PG8_STAGE_B(PG8_SB(0, 1), b2 + hstepB); PG8_STAGE_A(PG8_SA(0, 0), a2, x00, x01);
            PG8_WAIT_V8R(relax); PG8_WAIT_L(0); PG8_BAR; if (!cur.half) { PG8_MMA(1, 0, At, B0); PG8_MMA(1, 1, At, B1); } PG8_BAR; PG8_SCHED;
            PG8_LDB(B0, 1, 0); PG8_LDB(B1, 1, 1); PG8_SCHED; PG8_LDA(At, 1, 0); PG8_STAGE_A(PG8_SA(0, 1), a2, x10, x11);
            PG8_WAIT_V(8); PG8_WAIT_L(0); PG8_BAR; PG8_MMA(0, 0, At, B0); PG8_MMA(0, 1, At, B1); PG8_BAR; PG8_SCHED;
            PG8_LDA(At, 1, 1); PG8_STAGE_B(PG8_SB(1, 0), b3); PG8_STAGE_B(PG8_SB(1, 1), b3 + hstepB); PG8_STAGE_A(PG8_SA(1, 0), a3, x00, x01);
            PG8_WAIT_V(8); PG8_WAIT_L(0); PG8_BAR; if (!cur.half) { PG8_MMA(1, 0, At, B0); PG8_MMA(1, 1, At, B1); } PG8_BAR; PG8_SCHED;
        }
        if constexpr (ALIGN_EPI) { if (wr == 0) PG8_BAR; }
        if constexpr (FP8) asm volatile("s_nop 15\n\ts_nop 15" ::: "memory");
        if constexpr (!Epi::AFTER_DRAIN) { int fr_ = fr, fq_ = fq; asm volatile("" : "+v"(fr_), "+v"(fq_));
            E(acc, cur, wr, wc, fr_, fq_); }
        if (!has_next) break;
#pragma unroll
        for (int a = 0; a < 2; ++a)
#pragma unroll
            for (int b = 0; b < 2; ++b)
#pragma unroll
                for (int m = 0; m < 4; ++m)
#pragma unroll
                    for (int n = 0; n < 2; ++n) acc[a][b][m][n] = (f32x4){0.f, 0.f, 0.f, 0.f};
        cur = nxt; cA = nA; cB = nB; cB2 = nB2; c00 = n00; c01 = n01; c10 = n10; c11 = n11; ++ui;
        if constexpr (ALIGN_EPI) { if (wr == 1) PG8_BAR; }
    }
    PG8_WAIT_V(0);
    if constexpr (!ALIGN_EPI) { if (wr == 0) PG8_BAR; }
    PG8_BAR;
    if constexpr (Epi::AFTER_DRAIN) { E.fused(acc, cur, wr, wc, fr, fq, lds, wid, lane); }
#undef PG8_SA
#undef PG8_SB
#undef PG8_STAGE_A
#undef PG8_STAGE_B
#undef PG8_LDA
#undef PG8_LDB
#undef PG8_MMA
#undef PG8_WAIT_V
#undef PG8_WAIT_V8R
#undef PG8_WAIT_L
#undef PG8_BAR
#undef PG8_SCHED
#undef PG8_MKVO
}
}
using pg8::Unit;

#define XB_TMO      128
#define XB_XCNT(j)  (256  + 64 * (j))
#define XB_XSUB(j)  (1280 + 64 * (j))
#define XB_XGEN(j)  (2304 + 64 * (j))
#define XB_TOP      3328
#define XB_TOPGEN   3392
#define XCD_BAR_WORDS 3456
#define XB_SPIN_CAP (1u << 22)

__device__ __forceinline__ unsigned xb_ld(unsigned* p)              { return __hip_atomic_load(p, __ATOMIC_RELAXED, __HIP_MEMORY_SCOPE_AGENT); }
__device__ __forceinline__ unsigned xb_add(unsigned* p, unsigned v) { return __hip_atomic_fetch_add(p, v, __ATOMIC_RELAXED, __HIP_MEMORY_SCOPE_AGENT); }
__device__ __forceinline__ unsigned xb_xcc_id() { return (unsigned)__builtin_amdgcn_s_getreg((3 << 11) | 20) & 0xFu; }
#define XB_SPIN(cond, bar) do { unsigned _sp = 0; while (cond) { __builtin_amdgcn_s_sleep(1); \
    if ((++_sp & 255u) == 0u) { if (xb_ld(&(bar)[XB_TMO])) break; if (_sp > XB_SPIN_CAP) { atomicAdd(&(bar)[XB_TMO], 1u); break; } } } } while (0)

struct XcdBarrier { unsigned* bar; unsigned x; volatile LAS unsigned* st; };

__device__ __forceinline__ XcdBarrier xcd_barrier_post(unsigned* bar, volatile LAS unsigned* st) {
    XcdBarrier b; b.bar = bar; b.x = xb_xcc_id(); b.st = st;
    if (threadIdx.x == 0) (void)xb_add(&bar[XB_XCNT(b.x)], 1u);
    return b;
}
__device__ __forceinline__ void xcd_barrier_complete(unsigned* bar, unsigned x, unsigned& nloc, unsigned& nx) {
    const unsigned G = gridDim.x * gridDim.y * gridDim.z;
    unsigned sum, cnt, mine, sp = 0u;
    for (;;) {
        sum = 0u; cnt = 0u; mine = 0u;
#pragma unroll
        for (unsigned j = 0; j < 16; ++j) { const unsigned c = xb_ld(&bar[XB_XCNT(j)]); sum += c; cnt += (c > 0u) ? 1u : 0u; mine = (j == x) ? c : mine; }
        if (sum == G) break;
        __builtin_amdgcn_s_sleep(1);
        if ((++sp & 255u) == 0u) { if (xb_ld(&bar[XB_TMO])) break; if (sp > XB_SPIN_CAP) { atomicAdd(&bar[XB_TMO], 1u); break; } }
    }
    nloc = mine > 0u ? mine : 1u; nx = cnt > 0u ? cnt : 1u;
}
__device__ __forceinline__ void xcd_barrier(const XcdBarrier& b) {
    asm volatile("s_waitcnt vmcnt(0)" ::: "memory");
    __syncthreads();
    if (threadIdx.x == 0) {
        unsigned* bar = b.bar;
        __builtin_amdgcn_s_waitcnt(0);
        unsigned nloc = b.st[0], nx = b.st[1];
        if (nloc == 0u) { xcd_barrier_complete(bar, b.x, nloc, nx); b.st[0] = nloc; b.st[1] = nx; }
        const unsigned old = xb_add(&bar[XB_XSUB(b.x)], 1u);
        const unsigned gen = old / nloc;
        if (old + 1u == (gen + 1u) * nloc) {
            __builtin_amdgcn_fence(__ATOMIC_RELEASE, "agent");
            asm volatile("s_waitcnt vmcnt(0)" ::: "memory");
            const unsigned og = xb_add(&bar[XB_TOP], 1u);
            const unsigned tg = og / nx;
            if (og + 1u == (tg + 1u) * nx) xb_add(&bar[XB_TOPGEN], 1u);
            else XB_SPIN(xb_ld(&bar[XB_TOPGEN]) == tg, bar);
            __builtin_amdgcn_fence(__ATOMIC_ACQUIRE, "agent");
            xb_add(&bar[XB_XGEN(b.x)], 1u);
            asm volatile("s_waitcnt vmcnt(0)" ::: "memory");
        } else {
            XB_SPIN(xb_ld(&bar[XB_XGEN(b.x)]) == gen, bar);
            __builtin_amdgcn_fence(__ATOMIC_ACQUIRE, "agent");
            asm volatile("s_waitcnt vmcnt(0)" ::: "memory");
        }
    }
    __syncthreads();
}

struct Args { const float* in[34]; float* out; unsigned char* ws; int ph_lo, ph_hi; };

struct Frame {
    LAS unsigned char* lds;
    int tid, lane, wave, vcu, G;
    const float* const* in;
    float* out; unsigned char* ws;
};
#define WSP(T_, off) ((T_*)(F.ws + (off)))

struct SchedInProj {
    const char* XN; const char* WQKU; const char* WV; int G, c;
    __device__ __forceinline__ bool next(int i, Unit& u) const { const int L = i * G + c; if (L >= 2144) return false; u.aux = 0;
        if (L < 1536) { u.pm = L / 6; u.pn = L % 6; u.grp = 0; } else if (L < 1600) { const int r = L - 1536; u.pm = 256 + (r >> 2); u.pn = 2 + (r & 3); u.grp = 0; }
        else { const int r = L - 1600; u.pm = r & 1; u.pn = r >> 1; u.grp = 1; } return true; }
    __device__ __forceinline__ unsigned arow(const Unit& u, int j) const { return (unsigned)(u.pm * 256 + j); }
    __device__ __forceinline__ const char* abase(const Unit& u) const { return u.grp ? WV : XN; }
    __device__ __forceinline__ const char* bbase(const Unit& u) const { return (u.grp ? XN : WQKU) + (size_t)u.pn * 256 * 1024; }
};
struct SchedGrid {
    const char* A; const char* B; int ldb, nN, n, G, c;
    __device__ __forceinline__ bool next(int i, Unit& u) const { const int L = i * G + c; if (L >= n) return false; u.pm = L / nN; u.pn = L % nN; u.grp = 0; u.aux = 0; return true; }
    __device__ __forceinline__ unsigned arow(const Unit& u, int j) const { return (unsigned)(u.pm * 256 + j); }
    __device__ __forceinline__ const char* abase(const Unit&) const { return A; }
    __device__ __forceinline__ const char* bbase(const Unit& u) const { return B + (size_t)u.pn * 256 * ldb * 2; }
};
struct SchedS5 {
    const char* A; const char* B; int ldb, rows_b, nM, nN, n, G, c; size_t abytes;
    __device__ __forceinline__ bool next(int i, Unit& u) const { const int L = i * G + c; if (L >= n) return false; const int per = nM * nN; u.grp = L / per; const int r = L % per; u.pm = r / nN; u.pn = r % nN; u.aux = 0; u.half = (nM == 9 && u.pm == 8) ? 1 : 0; return true; }
    __device__ __forceinline__ unsigned arow(const Unit& u, int j) const { return (unsigned)(u.pm * 256 + j); }
    __device__ __forceinline__ const char* abase(const Unit& u) const { return A + (size_t)u.grp * abytes; }
    __device__ __forceinline__ const char* bbase(const Unit& u) const { return B + ((size_t)u.grp * rows_b + (size_t)u.pn * 256) * ldb * 2; }
};
struct SchedMoe {
    const char* A; const char* B; const LAS int* toff; const int* gcnt; const int* ltok; int glo, ghi, nN, ldb, rows_b, gather, G, c;
    __device__ __forceinline__ bool next(int i, Unit& u) const {
        const int L = i * G + c; const int t0 = toff[glo], t1 = toff[ghi]; if (L >= (t1 - t0) * nN) return false;
        const int mt = t0 + L / nN; u.pn = L % nN;
        int lo = glo, hi = ghi;
        while (hi - lo > 1) { const int mid = (lo + hi) >> 1; if (toff[mid] <= mt) lo = mid; else hi = mid; }
        u.grp = lo; u.pm = mt - toff[lo]; u.aux = mt; return true; }
    __device__ __forceinline__ unsigned arow(const Unit& u, int j) const {
        if (gather) { int idx = u.pm * 256 + j; const int cn = gcnt[u.grp]; idx = idx < cn ? idx : cn - 1; return (unsigned)ltok[u.grp * LISTCAP + idx]; }
        return (unsigned)(u.aux * 256 + j); }
    __device__ __forceinline__ const char* abase(const Unit&) const { return A; }
    __device__ __forceinline__ const char* bbase(const Unit& u) const { return B + ((size_t)(u.grp & 31) * rows_b + (size_t)u.pn * 256) * ldb * 2; }
};

struct SchedPair {
    const char* A; const char* B; const LAS int* toff2; int G, c; const LAS int* cn2;
    __device__ __forceinline__ bool next(int i, Unit& u) const {
        const int L = i * G + c; const int tot = toff2[NPAIR]; if (L >= tot * 4) return false;
        const int mt = L >> 2; u.pn = L & 3; int lo = 0, hi = NPAIR;
        while (hi - lo > 1) { const int mid = (lo + hi) >> 1; if (toff2[mid] <= mt) lo = mid; else hi = mid; }
        u.grp = lo; u.pm = mt - toff2[lo]; u.aux = mt; u.half = (cn2[lo] - u.pm * 256) <= 128 ? 1 : 0; return true; }
    __device__ __forceinline__ unsigned arow(const Unit& u, int j) const { return (unsigned)(u.aux * 256 + j); }
    __device__ __forceinline__ const char* abase(const Unit&) const { return A; }
    __device__ __forceinline__ void experts(const Unit& u, int& ea, int& eb) const { const int gi = u.grp / 28, p = u.grp % 28; int a = 0; while (a < 6 && (a + 1) * 8 - ((a + 1) * (a + 2)) / 2 <= p) ++a;
        const int b = a + 1 + (p - (a * 8 - (a * (a + 1)) / 2)); ea = gi * 8 + a; eb = gi * 8 + b; }
    __device__ __forceinline__ const char* bbase(const Unit& u) const { int ea, eb; experts(u, ea, eb); return B + ((size_t)ea * 1024 + (size_t)u.pn * 256) * 512; }
    __device__ __forceinline__ const char* bbase2(const Unit& u) const { int ea, eb; experts(u, ea, eb); return B + ((size_t)eb * 1024 + (size_t)u.pn * 256) * 512; }
};

typedef const f32x4 (&AccRef)[2][2][4][2];
struct EpiInProj {
    static constexpr bool PERM = true, AFTER_DRAIN = false; static constexpr int F8SC = 0x7a7a7a7a; static constexpr int NST = 16;
    unsigned char* Q; unsigned char* Kb; bf16_t* A2; unsigned char* A28; unsigned char* Vt; const float* gq; const float* gk; const float* rope;
    __device__ __forceinline__ void operator()(AccRef acc, const Unit& u, int wr, int wc, int fr, int fq) const {
        if (u.grp == 1) {
            const int tok0 = u.pn * 256; int b, pos0; if (tok0 < T) { b = tok0 >> 12; pos0 = tok0 & 4095; } else { b = (tok0 - T) >> 8; pos0 = SEQ; }
#pragma unroll
            for (int ai = 0; ai < 2; ++ai)
#pragma unroll
                for (int m = 0; m < 4; ++m) {
                    const int vcol = u.pm * 256 + ai * 128 + wr * 64 + m * 16 + fr;
                    unsigned char* rowp = Vt + ((size_t)b * 512 + vcol) * KV + pos0;
#pragma unroll
                    for (int bj = 0; bj < 2; ++bj) {
                        const f32x4 v0 = acc[ai][bj][m][0] * 8.f, v1 = acc[ai][bj][m][1] * 8.f;
                        int w0 = 0, w1 = 0; w0 = __builtin_amdgcn_cvt_pk_fp8_f32(v0[0], v0[1], w0, false); w0 = __builtin_amdgcn_cvt_pk_fp8_f32(v0[2], v0[3], w0, true);
                        w1 = __builtin_amdgcn_cvt_pk_fp8_f32(v1[0], v1[1], w1, false); w1 = __builtin_amdgcn_cvt_pk_fp8_f32(v1[2], v1[3], w1, true);
                        u32x2 w; w.x = (unsigned)w0; w.y = (unsigned)w1; *(u32x2*)(rowp + bj * 128 + wc * 32 + 8 * fq) = w; }
                }
            return;
        }
        const int ctx = u.pm >= 256; const int kind = u.pn >> 1;
        if (kind == 2) {
#pragma unroll
            for (int ai = 0; ai < 2; ++ai)
#pragma unroll
                for (int m = 0; m < 4; ++m) {
                    const int row = u.pm * 256 + ai * 128 + wr * 64 + m * 16 + fr;
                    int b, pos; if (!ctx) { b = row >> 12; pos = row & 4095; } else { b = (row - T) >> 8; pos = (row - T) & 255; }
                    const int r2 = ctx ? (A2_LAT + b * 8 + (pos >> 5)) : (b * 128 + (pos >> 5));
#pragma unroll
                    for (int bj = 0; bj < 2; ++bj) {
                        const int col = (u.pn & 1) * 256 + bj * 128 + wc * 32 + 8 * fq; const int g = col >> 4, ch = col & 15;
                        const f32x4 v0 = acc[ai][bj][m][0], v1 = acc[ai][bj][m][1];
                        u32x4 w; w.x = cvt_pk_bf16(v0[0], v0[1]); w.y = cvt_pk_bf16(v0[2], v0[3]); w.z = cvt_pk_bf16(v1[0], v1[1]); w.w = cvt_pk_bf16(v1[2], v1[3]);
                        *(u32x4*)(A2 + ((size_t)g * A2_ROWS + r2) * A2_LD + (pos & 31) * 16 + ch) = w;
                        *(u32x2*)(A28 + ((size_t)g * A2_ROWS + r2) * 768 + (pos & 31) * 16 + ch) = pack8_fp8(v0[0], v0[1], v0[2], v0[3], v1[0], v1[1], v1[2], v1[3]); }
                }
            return;
        }
        const int chunk = (u.pn & 1) * 4 + wc, dbase = (fq >> 1) * 32 + (fq & 1) * 8, axis = fq >> 1, i0 = (fq & 1) * 8;
        const float* gs = kind == 0 ? gq : gk;
        const f32x4 ga0 = *(const f32x4*)(gs + dbase), ga1 = *(const f32x4*)(gs + dbase + 4), gb0 = *(const f32x4*)(gs + dbase + 16), gb1 = *(const f32x4*)(gs + dbase + 20);
        const float qs = kind == 0 ? C2 * 16.f : 1.f;
#pragma unroll
        for (int ai = 0; ai < 2; ++ai)
#pragma unroll
            for (int m = 0; m < 4; ++m) {
                const int row = u.pm * 256 + ai * 128 + wr * 64 + m * 16 + fr;
                int b, pos; if (!ctx) { b = row >> 12; pos = row & 4095; } else { b = (row - T) >> 8; pos = (row - T) & 255; }
                const f32x4 a0 = acc[ai][0][m][0], a1 = acc[ai][0][m][1], b0 = acc[ai][1][m][0], b1 = acc[ai][1][m][1];
                float ss = (a0[0] * a0[0] + a0[1] * a0[1] + a0[2] * a0[2] + a0[3] * a0[3]) + (a1[0] * a1[0] + a1[1] * a1[1] + a1[2] * a1[2] + a1[3] * a1[3])
                         + (b0[0] * b0[0] + b0[1] * b0[1] + b0[2] * b0[2] + b0[3] * b0[3]) + (b1[0] * b1[0] + b1[1] * b1[1] + b1[2] * b1[2] + b1[3] * b1[3]);
                ss += __shfl_xor(ss, 16); ss += __shfl_xor(ss, 32);
                const float rn = qs / sqrtf(ss * (1.f / 64.f) + RMS_EPS);
                f32x4 y0 = a0 * rn * ga0, y1 = a1 * rn * ga1, z0 = b0 * rn * gb0, z1 = b1 * rn * gb1;
                if (!ctx) {
                    const int p = axis ? (pos & 63) : (pos >> 6); const float* cp = rope + p * 16 + i0;
                    const f32x4 c0 = *(const f32x4*)cp, c1 = *(const f32x4*)(cp + 4), s0 = *(const f32x4*)(cp + 1024), s1 = *(const f32x4*)(cp + 1028);
                    const f32x4 o0 = y0 * c0 - z0 * s0, o1 = y1 * c1 - z1 * s1, p0 = z0 * c0 + y0 * s0, p1 = z1 * c1 + y1 * s1;
                    y0 = o0; y1 = o1; z0 = p0; z1 = p1;
                }
                int a0_ = 0, a1_ = 0, b0_ = 0, b1_ = 0;
                a0_ = __builtin_amdgcn_cvt_pk_fp8_f32(y0[0], y0[1], a0_, false); a0_ = __builtin_amdgcn_cvt_pk_fp8_f32(y0[2], y0[3], a0_, true); a1_ = __builtin_amdgcn_cvt_pk_fp8_f32(y1[0], y1[1], a1_, false); a1_ = __builtin_amdgcn_cvt_pk_fp8_f32(y1[2], y1[3], a1_, true);
                b0_ = __builtin_amdgcn_cvt_pk_fp8_f32(z0[0], z0[1], b0_, false); b0_ = __builtin_amdgcn_cvt_pk_fp8_f32(z0[2], z0[3], b0_, true); b1_ = __builtin_amdgcn_cvt_pk_fp8_f32(z1[0], z1[1], b1_, false); b1_ = __builtin_amdgcn_cvt_pk_fp8_f32(z1[2], z1[3], b1_, true);
                u32x2 w0, w1; w0.x = (unsigned)a0_; w0.y = (unsigned)a1_; w1.x = (unsigned)b0_; w1.y = (unsigned)b1_;
                unsigned char* dst = (kind == 0 ? Q + (size_t)row * 512 : Kb + ((size_t)b * KV + (ctx ? SEQ + pos : pos)) * 512) + chunk * 64 + dbase;
                *(u32x2*)dst = w0; *(u32x2*)(dst + 16) = w1;
            }
    }
};
struct EpiS5State {
    static constexpr bool PERM = false, AFTER_DRAIN = false; static constexpr int F8SC = 0x7f7f7f7f; static constexpr int NST = 32;
    float* Sb;
    __device__ __forceinline__ void operator()(AccRef acc, const Unit& u, int wr, int wc, int fr, int fq) const {
#pragma unroll
        for (int ai = 0; ai < 2; ++ai)
#pragma unroll
            for (int m = 0; m < 4; ++m) {
                const int row = u.pm * 256 + ai * 128 + wr * 64 + m * 16 + fr;
                float* rowp = Sb + ((size_t)u.grp * A2_ROWS + row) * 256 + wc * 32 + 4 * fq;
#pragma unroll
                for (int bj = 0; bj < 2; ++bj)
#pragma unroll
                    for (int n = 0; n < 2; ++n) *(f32x4*)(rowp + bj * 128 + n * 16) = acc[ai][bj][m][n];
            }
    }
};
__device__ __forceinline__ float gelu_tanh(float x) {
    const float z = 1.5957691216057308f * (x + 0.044715f * x * x * x);
    return x * sigmoidf_(z);
}
struct EpiS5Out {
    static constexpr bool PERM = true, AFTER_DRAIN = false; static constexpr int F8SC = 0x79797979;        static constexpr int NST = 16;
    unsigned char* Yg;
    __device__ __forceinline__ void operator()(AccRef acc, const Unit& u, int wr, int wc, int fr, int fq) const {
#pragma unroll
        for (int ai = 0; ai < 2; ++ai)
#pragma unroll
            for (int m = 0; m < 4; ++m) {
                const int row = u.pm * 256 + ai * 128 + wr * 64 + m * 16 + fr; const int b = row >> 7, ck = row & 127;
#pragma unroll
                for (int bj = 0; bj < 2; ++bj) {
                    const int col = u.pn * 256 + bj * 128 + wc * 32 + 8 * fq; const int tl = col >> 4, ch = col & 15;
                    const f32x4 v0 = acc[ai][bj][m][0], v1 = acc[ai][bj][m][1];
                    *(u32x2*)(Yg + ((size_t)b * SEQ + ck * 32 + tl) * 512 + u.grp * 16 + ch) = pack8_fp8(gelu_tanh(v0[0]), gelu_tanh(v0[1]), gelu_tanh(v0[2]), gelu_tanh(v0[3]), gelu_tanh(v1[0]), gelu_tanh(v1[1]), gelu_tanh(v1[2]), gelu_tanh(v1[3])); }
            }
    }
};
struct EpiGlu {
    static constexpr bool PERM = true, AFTER_DRAIN = false; static constexpr int F8SC = 0x7a7a7a7a; static constexpr int NST = 16;
    const unsigned char* Yg; const float* bglu; bf16_t* AO;
    __device__ __forceinline__ void operator()(AccRef acc, const Unit& u, int wr, int wc, int fr, int fq) const {
#pragma unroll
        for (int ai = 0; ai < 2; ++ai)
#pragma unroll
            for (int m = 0; m < 4; ++m) {
                const int row = u.pm * 256 + ai * 128 + wr * 64 + m * 16 + fr;
#pragma unroll
                for (int bj = 0; bj < 2; ++bj) {
                    const int col = u.pn * 256 + bj * 128 + wc * 32 + 8 * fq;
                    const u32x2 y8 = *(const u32x2*)(Yg + (size_t)row * 512 + col);
                    const f32x2 ya = __builtin_amdgcn_cvt_pk_f32_fp8((int)y8.x, false), yb = __builtin_amdgcn_cvt_pk_f32_fp8((int)y8.x, true), yc = __builtin_amdgcn_cvt_pk_f32_fp8((int)y8.y, false), yd = __builtin_amdgcn_cvt_pk_f32_fp8((int)y8.y, true);
                    const f32x4 b0 = *(const f32x4*)(bglu + col), b1 = *(const f32x4*)(bglu + col + 4);
                    const f32x4 v0 = acc[ai][bj][m][0] + b0, v1 = acc[ai][bj][m][1] + b1;
                    u32x4 w;
                    w.x = cvt_pk_bf16(ya[0] * sigmoidf_(v0[0]), ya[1] * sigmoidf_(v0[1])); w.y = cvt_pk_bf16(yb[0] * sigmoidf_(v0[2]), yb[1] * sigmoidf_(v0[3]));
                    w.z = cvt_pk_bf16(yc[0] * sigmoidf_(v1[0]), yc[1] * sigmoidf_(v1[1])); w.w = cvt_pk_bf16(yd[0] * sigmoidf_(v1[2]), yd[1] * sigmoidf_(v1[3]));
                    *(u32x4*)(AO + (size_t)row * 1024 + 512 + col) = w; }
            }
    }
};
struct EpiOut {
    static constexpr bool PERM = true, AFTER_DRAIN = false; static constexpr int F8SC = 0x7f7f7f7f; static constexpr int NST = 16;
    const float* x; const float* mod; bf16_t* x1b;
    __device__ __forceinline__ void operator()(AccRef acc, const Unit& u, int wr, int wc, int fr, int fq) const {
        const int b = (u.pm * 256) >> 12; const float* g1 = mod + (size_t)b * 6144 + 2048;
#pragma unroll
        for (int ai = 0; ai < 2; ++ai)
#pragma unroll
            for (int m = 0; m < 4; ++m) {
                const size_t row = (size_t)u.pm * 256 + ai * 128 + wr * 64 + m * 16 + fr;
#pragma unroll
                for (int bj = 0; bj < 2; ++bj) { const int col = u.pn * 256 + bj * 128 + wc * 32 + 8 * fq;
                    const f32x4 x0 = *(const f32x4*)(x + row * 1024 + col), x1 = *(const f32x4*)(x + row * 1024 + col + 4), g0 = *(const f32x4*)(g1 + col), g1v = *(const f32x4*)(g1 + col + 4);
                    const f32x4 v0 = x0 + g0 * acc[ai][bj][m][0], v1 = x1 + g1v * acc[ai][bj][m][1];
                    u32x4 w; w.x = cvt_pk_bf16(v0[0], v0[1]); w.y = cvt_pk_bf16(v0[2], v0[3]); w.z = cvt_pk_bf16(v1[0], v1[1]); w.w = cvt_pk_bf16(v1[2], v1[3]);
                    *(u32x4*)(x1b + row * 1024 + col) = w; }
            }
    }
};
struct EpiGateUp {
    static constexpr bool PERM = true, AFTER_DRAIN = false; static constexpr int F8SC = 0x7f7f7f7f; static constexpr int NST = 8;
    unsigned char* H2; const int* gcnt; const float* lw; const int* lrow; const LAS int* toff2; unsigned char* trash;
    __device__ __forceinline__ void operator()(AccRef acc, const Unit& u, int wr, int wc, int fr, int fq) const {
        const int cn = gcnt[u.grp];
#pragma unroll
        for (int ai = 0; ai < 2; ++ai)
#pragma unroll
            for (int m = 0; m < 4; ++m) {
                const int idx = u.pm * 256 + ai * 128 + wr * 64 + m * 16 + fr; const bool valid = idx < cn; const int li = u.grp * LISTCAP + (valid ? idx : 0);
                const int lr = lrow[li]; const float wgt = valid ? lw[li] * (1.f / 32.f) : 0.f;
                const size_t row2 = (size_t)toff2[lr >> 17] * 256 + ((lr >> 1) & 0xffff);
                unsigned char* dst = valid ? H2 + row2 * 1024 + (lr & 1) * 512 + u.pn * 128 + wc * 32 + 8 * fq : trash + 8 * fq;
                const f32x4 g0 = acc[ai][0][m][0] * (1.f / 32.f), g1 = acc[ai][0][m][1] * (1.f / 32.f), u0 = acc[ai][1][m][0] * wgt, u1 = acc[ai][1][m][1] * wgt;
                int w0 = 0, w1 = 0;
                w0 = __builtin_amdgcn_cvt_pk_fp8_f32(g0[0] * sigmoidf_(g0[0]) * u0[0], g0[1] * sigmoidf_(g0[1]) * u0[1], w0, false); w0 = __builtin_amdgcn_cvt_pk_fp8_f32(g0[2] * sigmoidf_(g0[2]) * u0[2], g0[3] * sigmoidf_(g0[3]) * u0[3], w0, true);
                w1 = __builtin_amdgcn_cvt_pk_fp8_f32(g1[0] * sigmoidf_(g1[0]) * u1[0], g1[1] * sigmoidf_(g1[1]) * u1[1], w1, false); w1 = __builtin_amdgcn_cvt_pk_fp8_f32(g1[2] * sigmoidf_(g1[2]) * u1[2], g1[3] * sigmoidf_(g1[3]) * u1[3], w1, true);
                u32x2 o8; o8.x = (unsigned)w0; o8.y = (unsigned)w1;
                *(u32x2*)dst = o8;
            }
    }
};
struct EpiDown2 {
    static constexpr bool PERM = true, AFTER_DRAIN = false; static constexpr int F8SC = 0x7f7f7f7f; static constexpr int NST = 32;
    const int* gcnt2; const int* ptok; const float* mod; const bf16_t* x1b; float* out; unsigned char* trash;
    __device__ __forceinline__ void operator()(AccRef acc, const Unit& u, int wr, int wc, int fr, int fq) const {
        const int cn = gcnt2[u.grp];
#pragma unroll
        for (int ai = 0; ai < 2; ++ai)
#pragma unroll
            for (int m = 0; m < 4; ++m) {
                const int idx = u.pm * 256 + ai * 128 + wr * 64 + m * 16 + fr; const bool valid = idx < cn;
                const int tok = ptok[u.grp * LISTCAP + (valid ? idx : 0)];
                const float* g2 = mod + (size_t)(tok >> 12) * 6144 + 5120; float* orow = valid ? out + (size_t)tok * 1024 : (float*)trash;
#pragma unroll
                for (int bj = 0; bj < 2; ++bj) { const int col = u.pn * 256 + bj * 128 + wc * 32 + 8 * fq; const int ocol = valid ? col : 8 * fq;
                    const f32x4 g0 = *(const f32x4*)(g2 + col) * (1.f / 16.f), g1 = *(const f32x4*)(g2 + col + 4) * (1.f / 16.f);
                    const u32x4 xa = *(const u32x4*)(x1b + (size_t)tok * 1024 + col);
                    const f32x4 v0 = g0 * acc[ai][bj][m][0], v1 = g1 * acc[ai][bj][m][1];
                    f32x4 o0, o1;
                    o0[0] = bf_lo(xa.x) + v0[0]; o0[1] = bf_hi(xa.x) + v0[1]; o0[2] = bf_lo(xa.y) + v0[2]; o0[3] = bf_hi(xa.y) + v0[3];
                    o1[0] = bf_lo(xa.z) + v1[0]; o1[1] = bf_hi(xa.z) + v1[1]; o1[2] = bf_lo(xa.w) + v1[2]; o1[3] = bf_hi(xa.w) + v1[3];
                    *(f32x4*)(orow + ocol) = o0; *(f32x4*)(orow + ocol + 4) = o1; }
            }
    }
};

struct TrItem { const float* W; bf16_t* d; int K, N, k0, n0, rowoff, qkperm, fp8; float sc; };
__device__ __forceinline__ int qk_row(int n) { const int blk = n & ~511, nl = n & 511, chunk = nl >> 6, d = nl & 63; const int a = d >> 5, bj = (d >> 4) & 1, f1 = (d >> 3) & 1, e = d & 7;
    return blk + (chunk >> 2) * 256 + 128 * bj + 32 * (chunk & 3) + 8 * (a * 2 + f1) + e; }
__device__ __forceinline__ TrItem tr_decode(const float* const* in, unsigned char* ws, int it) {
    TrItem t;
    const float* W; bf16_t* d; int K, N, mode, sub;
    if (it < 1024) { W = in[7]; K = 1024; N = 2048; d = (bf16_t*)(ws + WS_WQKU); mode = 1; sub = it; }
    else if (it < 1024 + 128) { W = in[23]; K = 512; N = 512; d = (bf16_t*)(ws + WS_WGLU); mode = 5; sub = it - 1024; }
    else if (it < 1024 + 128 + 512) { W = in[25]; K = 1024; N = 1024; d = (bf16_t*)(ws + WS_WOUT); mode = 0; sub = it - 1152; }
    else { const int r = it - 1664, e = r / 768, q = r % 768, which = q >> 8; sub = q & 255;
        if (which == 0) { W = in[31] + (size_t)e * 1024 * 512; K = 1024; N = 512; d = (bf16_t*)(ws + WS_WGU + (size_t)e * 1024 * 1024); mode = 2; }
        else if (which == 1) { W = in[32] + (size_t)e * 1024 * 512; K = 1024; N = 512; d = (bf16_t*)(ws + WS_WGU + (size_t)e * 1024 * 1024); mode = 3; }
        else { W = in[33] + (size_t)e * 512 * 1024; K = 512; N = 1024; d = (bf16_t*)(ws + WS_WD + (size_t)e * 1024 * 512); mode = 4; } }
    const int nblk = N / 32, kb = sub / nblk, nb = sub % nblk; t.W = W; t.K = K; t.N = N; t.k0 = kb * 64; t.n0 = nb * 32;
    const int n0 = t.n0; int ro = 0;
    if (mode == 1) { if (n0 >= 1024 && n0 < 1536) { d = (bf16_t*)(ws + WS_WV); ro = -1024; } else if (n0 >= 1536) ro = -512; }
    else if (mode == 2) ro = (n0 >> 7) * 128;
    else if (mode == 3) ro = (n0 >> 7) * 128 + 128;
    t.d = d; t.rowoff = ro; t.qkperm = (mode == 1 && n0 < 1024) ? 1 : 0; t.fp8 = (mode >= 1 && mode <= 5) ? 1 : 0; t.sc = mode == 4 ? 16.f : 32.f; return t;
}
__device__ __forceinline__ void tr_load(const TrItem& t, int lane, f32x4 (&v)[8]) {
#pragma unroll
    for (int i = 0; i < 8; ++i) v[i] = *(const f32x4*)(t.W + (size_t)(t.k0 + (lane >> 3) + 8 * i) * t.N + t.n0 + (lane & 7) * 4);
}
__device__ __forceinline__ void tr_store(const TrItem& t, int lane, const f32x4 (&v)[8], LAS float* scr) {
#pragma unroll
    for (int i = 0; i < 8; ++i) { LAS float* p = scr + ((lane >> 3) + 8 * i) * 33 + (lane & 7) * 4; p[0] = v[i][0]; p[1] = v[i][1]; p[2] = v[i][2]; p[3] = v[i][3]; }
    asm volatile("s_waitcnt lgkmcnt(0)" ::: "memory");
#pragma unroll
    for (int j = 0; j < 4; ++j) { const int n = (lane >> 3) + 8 * j, kc = (lane & 7) * 8; const LAS float* q = scr + kc * 33 + n;
        u32x4 o; o.x = cvt_pk_bf16(q[0], q[33]); o.y = cvt_pk_bf16(q[2 * 33], q[3 * 33]); o.z = cvt_pk_bf16(q[4 * 33], q[5 * 33]); o.w = cvt_pk_bf16(q[6 * 33], q[7 * 33]);
        const int row = t.qkperm ? qk_row(t.n0 + n) : t.n0 + n + t.rowoff;
        if (t.fp8) { int w0 = 0, w1 = 0; const float SC = t.sc;
            w0 = __builtin_amdgcn_cvt_pk_fp8_f32(q[0] * SC, q[33] * SC, w0, false); w0 = __builtin_amdgcn_cvt_pk_fp8_f32(q[2 * 33] * SC, q[3 * 33] * SC, w0, true);
            w1 = __builtin_amdgcn_cvt_pk_fp8_f32(q[4 * 33] * SC, q[5 * 33] * SC, w1, false); w1 = __builtin_amdgcn_cvt_pk_fp8_f32(q[6 * 33] * SC, q[7 * 33] * SC, w1, true);
            u32x2 o8; o8.x = (unsigned)w0; o8.y = (unsigned)w1; *(u32x2*)((unsigned char*)t.d + (size_t)row * t.K + t.k0 + kc) = o8; }
        else *(u32x4*)(t.d + (size_t)row * t.K + t.k0 + kc) = o; }
    asm volatile("s_waitcnt lgkmcnt(0)" ::: "memory");
}
constexpr int NTR_NONEXP = 1664, NTR_ITEMS = 1664 + 32 * 768;
__device__ __forceinline__ void adaln_item(const float* c, const float* cctx, const float* wada, const float* bada, float* mod, int item, LAS float* L, int tid) {
    LAS float* st = L;
    LAS float* red = L + 17 * 1024;
    for (int idx = tid; idx < 17 * 1024; idx += 512) { const float v = idx < 16384 ? c[idx] : cctx[idx - 16384]; st[idx] = v / (1.f + __expf(-v)); }
    __syncthreads();
    const int n0 = item * 32, col = tid & 31, ks = tid >> 5;
    float acc[17];
#pragma unroll
    for (int r = 0; r < 17; ++r) acc[r] = 0.f;
    for (int kb = 0; kb < 64; kb += 16) { float w[16];
#pragma unroll
        for (int q = 0; q < 16; ++q) w[q] = wada[(size_t)(ks * 64 + kb + q) * 6144 + n0 + col];
#pragma unroll
        for (int q = 0; q < 16; ++q) { const int k = ks * 64 + kb + q;
#pragma unroll
            for (int r = 0; r < 17; ++r) acc[r] += st[r * 1024 + k] * w[q]; } }
#pragma unroll
    for (int r = 0; r < 17; ++r) red[(ks * 17 + r) * 32 + col] = acc[r];
    __syncthreads();
    for (int idx = tid; idx < 17 * 32; idx += 512) { const int r = idx >> 5, cc = idx & 31; float s = 0.f;
#pragma unroll
        for (int k = 0; k < 16; ++k) s += red[(k * 17 + r) * 32 + cc];
        mod[(size_t)r * 6144 + n0 + cc] = s + bada[n0 + cc]; }
    __syncthreads();
}
__device__ __forceinline__ void s5_disc(const float* are, const float* aim, const float* ldt, int dir, int g, int p, float& lr, float& li, float& cr, float& ci) {
    const float dt = expf(ldt[dir * 32 + g]); const float ar = are[(dir * 32 + g) * 64 + p], ai = aim[(dir * 32 + g) * 64 + p];
    const float mag = expf(ar * dt); float sn, cs; sincosf(ai * dt, &sn, &cs);
    lr = mag * cs; li = mag * sn;
    const float den = ar * ar + ai * ai, nr = lr - 1.f, ni = li;
    cr = (nr * ar + ni * ai) / den; ci = (ni * ar - nr * ai) / den;
}
__device__ __forceinline__ void s5_item_lag(const float* const* in, unsigned char* W2, int item, LAS float* L, int tid) {
    const int g = item >> 2, j0 = (item & 3) * 8;
    LAS float* lamj = L;
    LAS float* lam1 = L + 256;
    LAS float* Bb = L + 512;
    LAS float* Gm = L + 512 + 4096;
    LAS float* Cm = L + 512 + 8192;
    LAS float* Kt = L + 512 + 8192 + 2048;
    LAS float* coef = Kt + 512;
    if (tid < 128) { const int dir = tid >> 6, p = tid & 63; float lr, li, cr, ci; s5_disc(in[15], in[16], in[17], dir, g, p, lr, li, cr, ci);
        float pr = 1.f, pi = 0.f; for (int e = 0; e < j0; ++e) { const float t = pr * lr - pi * li; pi = pr * li + pi * lr; pr = t; }
        lamj[tid * 2] = pr; lamj[tid * 2 + 1] = pi; lam1[tid * 2] = lr; lam1[tid * 2 + 1] = li; coef[tid * 2] = cr; coef[tid * 2 + 1] = ci; }
    for (int idx = tid; idx < 1024; idx += 512) { const int ho = idx >> 6, p = idx & 63; Cm[idx * 2] = in[20][(g * 16 + ho) * 64 + p]; Cm[idx * 2 + 1] = in[21][(g * 16 + ho) * 64 + p]; }
    __syncthreads();
    for (int idx = tid; idx < 2048; idx += 512) { const int dir = idx >> 10, p = (idx >> 4) & 63, hi = idx & 15;
        const float br = in[18][((size_t)(dir * 32 + g) * 64 + p) * 16 + hi], bi = in[19][((size_t)(dir * 32 + g) * 64 + p) * 16 + hi];
        const float cr = coef[(dir * 64 + p) * 2], ci = coef[(dir * 64 + p) * 2 + 1];
        Bb[idx * 2] = cr * br - ci * bi; Bb[idx * 2 + 1] = cr * bi + ci * br; }
    unsigned char* Wg = W2 + (size_t)g * 512 * 768;
    for (int j = j0; j < j0 + 8; ++j) {
        __syncthreads();
        for (int idx = tid; idx < 2048; idx += 512) { const int dp = idx >> 4; const float pr = lamj[dp * 2], pi = lamj[dp * 2 + 1], bbr = Bb[idx * 2], bbi = Bb[idx * 2 + 1];
            Gm[idx * 2] = pr * bbr - pi * bbi; Gm[idx * 2 + 1] = pr * bbi + pi * bbr; }
        __syncthreads();
        { const int dir = tid >> 8, ho = (tid >> 4) & 15, hi = tid & 15; float sacc = 0.f;
            for (int p = 0; p < 64; ++p) sacc += Cm[(ho * 64 + p) * 2] * Gm[((dir * 64 + p) * 16 + hi) * 2] - Cm[(ho * 64 + p) * 2 + 1] * Gm[((dir * 64 + p) * 16 + hi) * 2 + 1];
            Kt[tid] = sacc; }
        if (tid < 128) { const float pr = lamj[tid * 2], pi = lamj[tid * 2 + 1], lr = lam1[tid * 2], li = lam1[tid * 2 + 1]; lamj[tid * 2] = pr * lr - pi * li; lamj[tid * 2 + 1] = pr * li + pi * lr; }
        __syncthreads();
        if (j == 0) {
            for (int idx = tid; idx < 32 * 32; idx += 512) { const int t = idx >> 5, ho = (idx >> 1) & 15, hb = (idx & 1) * 8; float v[8];
#pragma unroll
                for (int e = 0; e < 8; ++e) { v[e] = Kt[ho * 16 + hb + e] + Kt[256 + ho * 16 + hb + e] + ((hb + e) == ho ? in[22][g * 16 + ho] : 0.f); }
                *(u32x2*)(Wg + (size_t)(t * 16 + ho) * 768 + t * 16 + hb) = pack8_fp8(v[0] * 64.f, v[1] * 64.f, v[2] * 64.f, v[3] * 64.f, v[4] * 64.f, v[5] * 64.f, v[6] * 64.f, v[7] * 64.f); }
        } else {
            const int nb = 32 - j;
            for (int idx = tid; idx < 2 * nb * 32; idx += 512) { const int dir = idx / (nb * 32), r = idx % (nb * 32), q = r >> 5, ho = (r >> 1) & 15, hb = (r & 1) * 8;
                const int t = dir == 0 ? q + j : q, sx = dir == 0 ? q : q + j; const LAS float* kp = Kt + dir * 256 + ho * 16 + hb;
                *(u32x2*)(Wg + (size_t)(t * 16 + ho) * 768 + sx * 16 + hb) = pack8_fp8(kp[0] * 64.f, kp[1] * 64.f, kp[2] * 64.f, kp[3] * 64.f, kp[4] * 64.f, kp[5] * 64.f, kp[6] * 64.f, kp[7] * 64.f); }
        }
    }
    __syncthreads();
}
__device__ __forceinline__ void s5_item_state(const float* const* in, bf16_t* W1, unsigned char* W2, int item, LAS float* L, int tid) {
    const int g = item >> 1, dir = item & 1;
    LAS float* pw = L;
    LAS float* Bb = L + 33 * 128;
    LAS float* Cm = Bb + 2048;
    LAS float* coef = Cm + 2048;
    if (tid < 64) { const int p = tid; float lr, li, cr, ci; s5_disc(in[15], in[16], in[17], dir, g, p, lr, li, cr, ci);
        float pr = 1.f, pi = 0.f; for (int e = 0; e <= 32; ++e) { pw[(e * 64 + p) * 2] = pr; pw[(e * 64 + p) * 2 + 1] = pi; const float t = pr * lr - pi * li; pi = pr * li + pi * lr; pr = t; }
        coef[p * 2] = cr; coef[p * 2 + 1] = ci; }
    for (int idx = tid; idx < 1024; idx += 512) { const int ho = idx >> 6, p = idx & 63; Cm[idx * 2] = in[20][(g * 16 + ho) * 64 + p]; Cm[idx * 2 + 1] = in[21][(g * 16 + ho) * 64 + p]; }
    __syncthreads();
    for (int idx = tid; idx < 1024; idx += 512) { const int p = idx >> 4, hi = idx & 15;
        const float br = in[18][((size_t)(dir * 32 + g) * 64 + p) * 16 + hi], bi = in[19][((size_t)(dir * 32 + g) * 64 + p) * 16 + hi];
        const float cr = coef[p * 2], ci = coef[p * 2 + 1]; Bb[idx * 2] = cr * br - ci * bi; Bb[idx * 2 + 1] = cr * bi + ci * br; }
    __syncthreads();
    bf16_t* W1g = W1 + ((size_t)g * 256 + dir * 128) * 512;
    for (int idx = tid; idx < 128 * 64; idx += 512) { const int n = idx >> 6, kc = idx & 63, part = n >> 6, p = n & 63, s = kc >> 1, hb = (kc & 1) * 8;
        const int e = dir == 0 ? 31 - s : s; const float pr = pw[(e * 64 + p) * 2], pi = pw[(e * 64 + p) * 2 + 1]; float v[8];
#pragma unroll
        for (int q = 0; q < 8; ++q) { const float br = Bb[(p * 16 + hb + q) * 2], bi = Bb[(p * 16 + hb + q) * 2 + 1]; v[q] = part == 0 ? pr * br - pi * bi : pr * bi + pi * br; }
        u32x4 o; o.x = cvt_pk_bf16(v[0], v[1]); o.y = cvt_pk_bf16(v[2], v[3]); o.z = cvt_pk_bf16(v[4], v[5]); o.w = cvt_pk_bf16(v[6], v[7]);
        *(u32x4*)(W1g + (size_t)n * 512 + s * 16 + hb) = o; }
    unsigned char* W2g = W2 + (size_t)g * 512 * 768 + 512 + dir * 128;
    for (int idx = tid; idx < 512 * 16; idx += 512) { const int n = idx >> 4, cc = idx & 15, t = n >> 4, ho = n & 15, part = cc >> 3, p0 = (cc & 7) * 8;
        const int e = dir == 0 ? t + 1 : 32 - t; float v[8];
#pragma unroll
        for (int q = 0; q < 8; ++q) { const int p = p0 + q; const float pr = pw[(e * 64 + p) * 2], pi = pw[(e * 64 + p) * 2 + 1], c_r = Cm[(ho * 64 + p) * 2], c_i = Cm[(ho * 64 + p) * 2 + 1];
            v[q] = part == 0 ? (c_r * pr - c_i * pi) : -(c_r * pi + c_i * pr); }
        *(u32x2*)(W2g + (size_t)n * 768 + part * 64 + p0) = pack8_fp8(v[0] * 64.f, v[1] * 64.f, v[2] * 64.f, v[3] * 64.f, v[4] * 64.f, v[5] * 64.f, v[6] * 64.f, v[7] * 64.f); }
    __syncthreads();
}
__device__ __forceinline__ void wr_item(const float* wrg, const float* wre, bf16_t* Wr, int item, int tid) {
    const int r = item * 4 + (tid >> 7), k0 = (tid & 127) * 8; float v[8];
#pragma unroll
    for (int q = 0; q < 8; ++q) { const int k = k0 + q; v[q] = r < 4 ? wrg[k * 4 + r] : (r < 36 ? wre[k * 32 + (r - 4)] : 0.f); }
    u32x4 o; o.x = cvt_pk_bf16(v[0], v[1]); o.y = cvt_pk_bf16(v[2], v[3]); o.z = cvt_pk_bf16(v[4], v[5]); o.w = cvt_pk_bf16(v[6], v[7]);
    *(u32x4*)(Wr + (size_t)r * 1024 + k0) = o;
}
__device__ __forceinline__ void misc_item(const float* const* in, float* misc, int tid) {
    for (int idx = tid; idx < 1024; idx += 512) { const int pos = idx >> 4, i = idx & 15; const float inv = exp2f(-(float)i * (13.287712379549449f / 16.f));
        float sn, c; sincosf((float)pos * inv, &sn, &c); misc[64 + idx] = c; misc[64 + 1024 + idx] = sn; }
    if (tid < 64) {
        const float s1 = wave_sum(in[10][tid] * in[11][tid]), s2 = wave_sum(in[12][tid] * in[13][tid]);
        float gq = fabsf(in[8][tid]), gk = fabsf(in[9][tid]);
#pragma unroll
        for (int o = 1; o < 64; o <<= 1) { gq = fmaxf(gq, __shfl_xor(gq, o)); gk = fmaxf(gk, __shfl_xor(gk, o)); }
        if (tid == 0) { misc[0] = expf(s1) - expf(s2) + LAM_INIT; misc[1] = 8.f * 1.4426950408889634f * gq * gk; }
    }
}
constexpr int IT_ADA = 192, IT_ST = 64, IT_WR = 64, IT_MISC = 1;
constexpr int IT0 = IT_ADA, IT1 = IT0 + IT_ST, IT2 = IT1 + IT_WR, IT_END = IT2 + IT_MISC;
constexpr int S5_ITEMS = 128;
__device__ __forceinline__ void s5_matrix_items(Frame& F, int first, int stride) {
    LAS float* L = (LAS float*)F.lds;
    for (int it = first; it < S5_ITEMS; it += stride) s5_item_lag(F.in, WSP(unsigned char, WS_S5W2), it, L, F.tid);
}
__device__ __forceinline__ void p0_prologue(Frame& F) {
    LAS float* L = (LAS float*)F.lds; const int tid = F.tid;
    for (int it = F.vcu; it < IT_END; it += F.G) {
        if (it < IT0) adaln_item(F.in[1], F.in[3], F.in[4], F.in[5], WSP(float, WS_MOD), it, L, tid);
        else if (it < IT1) s5_item_state(F.in, WSP(bf16_t, WS_S5W1), WSP(unsigned char, WS_S5W2), it - IT0, L, tid);
        else if (it < IT2) wr_item(F.in[27], F.in[29], WSP(bf16_t, WS_WR), it - IT1, tid);
        else misc_item(F.in, WSP(float, WS_MISC), tid);
    }
    __syncthreads();
    LAS float* scr = L + F.wave * 4096;
    const int gw = F.vcu * 8 + F.wave, NGW = F.G * 8;
    for (int it = gw; it < NTR_NONEXP; it += 2 * NGW) {
        const bool two = it + NGW < NTR_NONEXP;
        const TrItem t0 = tr_decode(F.in, F.ws, it); const TrItem t1 = tr_decode(F.in, F.ws, two ? it + NGW : it);
        f32x4 v0[8], v1[8];
        tr_load(t0, F.lane, v0); tr_load(t1, F.lane, v1);
        tr_store(t0, F.lane, v0, scr);
        if (two) tr_store(t1, F.lane, v1, scr);
    }
    __syncthreads();
}

__device__ __forceinline__ void tr_expert_slice(Frame& F, int k) {
    LAS float* scr = (LAS float*)F.lds + F.wave * 4096;
    const int gw = F.vcu * 8 + F.wave, NGW = F.G * 8;
    const int it0 = NTR_NONEXP + (2 * k) * NGW + gw, it1 = it0 + NGW;
    if (it0 < NTR_ITEMS) {
        const bool two = it1 < NTR_ITEMS;
        const TrItem t0 = tr_decode(F.in, F.ws, it0); const TrItem t1 = tr_decode(F.in, F.ws, two ? it1 : it0);
        f32x4 v0[8], v1[8];
        tr_load(t0, F.lane, v0); tr_load(t1, F.lane, v1);
        tr_store(t0, F.lane, v0, scr);
        if (two) tr_store(t1, F.lane, v1, scr);
    }
    __syncthreads();
}

__device__ __forceinline__ void norm_mod_rows(Frame& F, const float* xa, int na, const float* xb, int nbr, const float* gain, const float* mod, int sh_off, int sc_off, unsigned char* dst) {
    const int gw = F.vcu * 8 + F.wave, NGW = F.G * 8, lane = F.lane, total = na + nbr, per = (total + NGW - 1) / NGW;
    const int r0 = gw * per, r1 = (r0 + per < total) ? r0 + per : total;
    int curb = -1; f32x4 gm[4], sh[4];
#pragma unroll
    for (int j = 0; j < 4; ++j) { gm[j] = (f32x4){0.f, 0.f, 0.f, 0.f}; sh[j] = gm[j]; }
#pragma unroll 1
    for (int base = r0; base < r1; base += 4) {
        f32x4 v[4][4];
#pragma unroll
        for (int q = 0; q < 4; ++q) { const int row = base + q < r1 ? base + q : r1 - 1; const float* src = row < na ? xa + (size_t)row * 1024 : xb + (size_t)(row - na) * 1024;
#pragma unroll
            for (int j = 0; j < 4; ++j) v[q][j] = *(const f32x4*)(src + 4 * (lane + 64 * j)); }
#pragma unroll
        for (int q = 0; q < 4; ++q) { const int row = base + q;
            if (row < r1) {
                const int b = row < na ? row >> 12 : 16;
                if (b != curb) { curb = b; const float* mb = mod + (size_t)b * 6144;
#pragma unroll
                    for (int j = 0; j < 4; ++j) { const int k0 = 4 * (lane + 64 * j); const f32x4 gv = *(const f32x4*)(gain + k0), sc = *(const f32x4*)(mb + sc_off + k0); gm[j] = gv * (1.f + sc); sh[j] = *(const f32x4*)(mb + sh_off + k0); } }
                float ss = 0.f;
#pragma unroll
                for (int j = 0; j < 4; ++j) ss += v[q][j][0] * v[q][j][0] + v[q][j][1] * v[q][j][1] + v[q][j][2] * v[q][j][2] + v[q][j][3] * v[q][j][3];
                const float r = 1.f / sqrtf(wave_sum(ss) * (1.f / 1024.f) + RMS_EPS);
#pragma unroll
                for (int j = 0; j < 4; ++j) { const int k0 = 4 * (lane + 64 * j);
                    const f32x4 y = v[q][j] * r * gm[j] + sh[j];
                    int w = 0; w = __builtin_amdgcn_cvt_pk_fp8_f32(y[0], y[1], w, false); w = __builtin_amdgcn_cvt_pk_fp8_f32(y[2], y[3], w, true);
                    *(int*)(dst + (size_t)row * 1024 + k0) = w; }
            }
        }
    }
}

constexpr int RT_WPITCH = 2064;
constexpr int RT_TAB = 48 * RT_WPITCH;
constexpr int RT_LOG = RT_TAB + 8192;
constexpr int RT_CNT = RT_LOG + 8 * 2368;
constexpr int RT_CNT2 = RT_CNT + 512;
constexpr int RT_RES = LDSCTL_OFF + 2048;
static_assert(RT_CNT2 + 896 <= LDSCTL_OFF && RT_RES + 9216 <= LDS_BYTES && RT_RES >= MISC_OFF + 128, "router scratch must not touch the LDS control words");
__device__ __forceinline__ void norm2_router_phase(Frame& F, const bf16_t* x1b, const float* gain, const float* mod, bf16_t* Tb, const bf16_t* Wr, const float* brg, const float* bre, int* gcnt, int* ltok, float* lw, int* gcnt2, int* lrow, int* ptok) {
    LAS unsigned char* lds = F.lds; const int tid = F.tid, lane = F.lane, wave = F.wave, r = lane & 15, q = lane >> 4;
    typedef float f32x4_t __attribute__((ext_vector_type(4)));
    for (int blk = F.vcu; blk < T / 256; blk += F.G) {
        const int b = (blk * 256) >> 12; const float* mb = mod + (size_t)b * 6144;
        for (int idx = tid; idx < 48 * 128; idx += 512) { const int row = idx >> 7, c = idx & 127; *(LAS u32x4*)(lds + row * RT_WPITCH + c * 16) = *(const u32x4*)(Wr + (size_t)row * 1024 + c * 8); }
        for (int idx = tid; idx < 1024; idx += 512) { ((LAS float*)(lds + RT_TAB))[idx] = gain[idx] * (1.f + mb[4096 + idx]); ((LAS float*)(lds + RT_TAB))[1024 + idx] = mb[3072 + idx]; }
        if (tid < 128) ((LAS int*)(lds + RT_CNT))[tid] = 0;
        if (tid < 224) ((LAS int*)(lds + RT_CNT2))[tid] = 0;
        __syncthreads();
        LAS float* lg = (LAS float*)(lds + RT_LOG + wave * 2368);
        LAS int* cl = (LAS int*)(lds + RT_CNT); LAS int* cl2 = (LAS int*)(lds + RT_CNT2);
        LAS int* res = (LAS int*)(lds + RT_RES);
#pragma unroll 1
        for (int grp = 0; grp < 2; ++grp) {
            const int row = blk * 256 + wave * 32 + grp * 16 + r;
            const bf16_t* src = x1b + (size_t)row * 1024 + 8 * q; unsigned char* dst8 = (unsigned char*)Tb + (size_t)row * 1024 + 8 * q;
            u32x4 raw[32];
#pragma unroll
            for (int st = 0; st < 32; ++st) raw[st] = *(const u32x4*)(src + 32 * st);
            float ss = 0.f;
#pragma unroll
            for (int st = 0; st < 32; ++st) { const u32x4 v = raw[st];
                ss += bf_lo(v.x) * bf_lo(v.x) + bf_hi(v.x) * bf_hi(v.x) + bf_lo(v.y) * bf_lo(v.y) + bf_hi(v.y) * bf_hi(v.y) + bf_lo(v.z) * bf_lo(v.z) + bf_hi(v.z) * bf_hi(v.z) + bf_lo(v.w) * bf_lo(v.w) + bf_hi(v.w) * bf_hi(v.w); }
            ss += __shfl_xor(ss, 16); ss += __shfl_xor(ss, 32);
            const float rn = 1.f / sqrtf(ss * (1.f / 1024.f) + RMS_EPS);
#pragma unroll
            for (int st = 0; st < 32; ++st) asm volatile("" : "+v"(raw[st]));
            f32x4_t acc0 = {0.f, 0.f, 0.f, 0.f}, acc1 = {0.f, 0.f, 0.f, 0.f}, acc2 = {0.f, 0.f, 0.f, 0.f};
            int qo = q, ro = r; asm volatile("" : "+v"(qo), "+v"(ro));
            const LAS unsigned char* tabp = lds + RT_TAB + 32 * qo; const LAS unsigned char* wp = lds + ro * RT_WPITCH + 16 * qo; const LAS unsigned char* wp2 = wp + 32 * RT_WPITCH;
#pragma unroll
            for (int st = 0; st < 32; ++st) { const u32x4 v = raw[st];
                const f32x4 g0 = *(const LAS f32x4*)(tabp + 128 * st), g1 = *(const LAS f32x4*)(tabp + 128 * st + 16), h0 = *(const LAS f32x4*)(tabp + 4096 + 128 * st), h1 = *(const LAS f32x4*)(tabp + 4096 + 128 * st + 16);
                const float y0 = bf_lo(v.x) * rn * g0[0] + h0[0], y1 = bf_hi(v.x) * rn * g0[1] + h0[1], y2 = bf_lo(v.y) * rn * g0[2] + h0[2], y3 = bf_hi(v.y) * rn * g0[3] + h0[3];
                const float y4 = bf_lo(v.z) * rn * g1[0] + h1[0], y5 = bf_hi(v.z) * rn * g1[1] + h1[1], y6 = bf_lo(v.w) * rn * g1[2] + h1[2], y7 = bf_hi(v.w) * rn * g1[3] + h1[3];
                u32x4 o; o.x = cvt_pk_bf16(y0, y1); o.y = cvt_pk_bf16(y2, y3); o.z = cvt_pk_bf16(y4, y5); o.w = cvt_pk_bf16(y6, y7);
                { int w0 = 0, w1 = 0;
                  w0 = __builtin_amdgcn_cvt_pk_fp8_f32(y0, y1, w0, false); w0 = __builtin_amdgcn_cvt_pk_fp8_f32(y2, y3, w0, true);
                  w1 = __builtin_amdgcn_cvt_pk_fp8_f32(y4, y5, w1, false); w1 = __builtin_amdgcn_cvt_pk_fp8_f32(y6, y7, w1, true);
                  u32x2 o8; o8.x = (unsigned)w0; o8.y = (unsigned)w1; *(u32x2*)(dst8 + 32 * st) = o8; }
                const bf16x8 af = __builtin_bit_cast(bf16x8, o);
                const bf16x8 b0 = *(const LAS bf16x8*)(wp + 64 * st), b1 = *(const LAS bf16x8*)(wp + 16 * RT_WPITCH + 64 * st), b2 = *(const LAS bf16x8*)(wp2 + 64 * st);
                acc0 = __builtin_amdgcn_mfma_f32_16x16x32_bf16(af, b0, acc0, 0, 0, 0); acc1 = __builtin_amdgcn_mfma_f32_16x16x32_bf16(af, b1, acc1, 0, 0, 0); acc2 = __builtin_amdgcn_mfma_f32_16x16x32_bf16(af, b2, acc2, 0, 0, 0);
                if ((st & 3) == 3) __builtin_amdgcn_sched_barrier(0); }
#pragma unroll
            for (int i = 0; i < 4; ++i) { lg[(4 * q + i) * 37 + r] = acc0[i]; lg[(4 * q + i) * 37 + 16 + r] = acc1[i]; if (r < 4) lg[(4 * q + i) * 37 + 32 + r] = acc2[i]; }
            asm volatile("s_waitcnt lgkmcnt(0)" ::: "memory");
            int e0 = 0, e1 = 0, r0 = 0, r1 = 0, pg = 0, rpp = 0, h0 = 0; float w0 = 0.f, w1 = 0.f;
            if (lane < 16) {
                const LAS float* lr = lg + lane * 37;
                float gl[4]; int gi = 0; float gm;
#pragma unroll
                for (int j = 0; j < 4; ++j) gl[j] = lr[j] + brg[j];
                gm = gl[0];
#pragma unroll
                for (int j = 1; j < 4; ++j) if (gl[j] > gm) { gm = gl[j]; gi = j; }
                float den = 0.f;
#pragma unroll
                for (int j = 0; j < 4; ++j) den += __expf(gl[j] - gm);
                const float pgrp = 1.f / den;
                float v1 = -3.0e38f, v2 = -3.0e38f; int i1 = 0, i2 = 0;
                for (int j = 0; j < 8; ++j) { const float v = lr[4 + gi * 8 + j] + bre[gi * 8 + j];
                    if (v > v1) { v2 = v1; i2 = i1; v1 = v; i1 = j; } else if (v > v2) { v2 = v; i2 = j; } }
                const float ex = __expf(v2 - v1); w0 = pgrp / (1.f + ex); w1 = pgrp * ex / (1.f + ex);
                e0 = gi * 8 + i1; e1 = 32 + gi * 8 + i2;
                r0 = atomicAdd((int*)&cl[e0], 1); r1 = atomicAdd((int*)&cl[e1], 1);
                { const int a = i1 < i2 ? i1 : i2, b = i1 < i2 ? i2 : i1; pg = gi * 28 + (a * 8 - (a * (a + 1)) / 2) + (b - a - 1); h0 = i1 < i2 ? 0 : 1; rpp = atomicAdd((int*)&cl2[pg], 1); }
            }
            if (lane < 16) { LAS int* rp = res + ((wave * 2 + grp) * 16 + lane) * 9; rp[0] = e0; rp[1] = e1; rp[2] = r0; rp[3] = r1; rp[4] = __builtin_bit_cast(int, w0); rp[5] = __builtin_bit_cast(int, w1); rp[6] = pg; rp[7] = rpp; rp[8] = h0; }
            asm volatile("s_waitcnt lgkmcnt(0)" ::: "memory");
        }
        __syncthreads();
        if (tid < 64) { const int n = cl[tid]; cl[64 + tid] = n > 0 ? atomicAdd(&gcnt[tid], n) : 0; }
        else if (tid < 64 + NPAIR) { const int q_ = tid - 64; const int n = cl2[q_]; cl2[NPAIR + q_] = n > 0 ? atomicAdd(&gcnt2[q_], n) : 0; }
        __syncthreads();
        if (lane < 16) {
#pragma unroll
            for (int grp = 0; grp < 2; ++grp) { const LAS int* rp = res + ((wave * 2 + grp) * 16 + lane) * 9; const int e0 = rp[0], e1 = rp[1];
                const int tok = blk * 256 + wave * 32 + grp * 16 + lane; const int p0 = cl[64 + e0] + rp[2], p1 = cl[64 + e1] + rp[3];
                ltok[e0 * LISTCAP + p0] = tok; lw[e0 * LISTCAP + p0] = __builtin_bit_cast(float, rp[4]); ltok[e1 * LISTCAP + p1] = tok; lw[e1 * LISTCAP + p1] = __builtin_bit_cast(float, rp[5]);
                const int pgx = rp[6], ppos = cl2[NPAIR + pgx] + rp[7], hs = rp[8];
                lrow[e0 * LISTCAP + p0] = (pgx << 17) | (ppos << 1) | hs; lrow[e1 * LISTCAP + p1] = (pgx << 17) | (ppos << 1) | (1 - hs); ptok[pgx * LISTCAP + ppos] = tok; }
        }
        __syncthreads();
    }
}

__device__ __forceinline__ void s5_scan_phase(Frame& F) {
    const int gt = F.vcu * 512 + F.tid;
    if (gt >= NB * SG * 2 * 64) return;
    const int p = gt & 63, dir = (gt >> 6) & 1, g = (gt >> 7) & 31, b = gt >> 12;
    float lr, li, cr, ci; s5_disc(F.in[15], F.in[16], F.in[17], dir, g, p, lr, li, cr, ci);
#pragma unroll
    for (int e = 0; e < 5; ++e) { const float t = lr * lr - li * li; li = 2.f * lr * li; lr = t; }
    const float* Sb = WSP(float, WS_SB) + (size_t)g * A2_ROWS * 256 + dir * 128 + p;
    unsigned char* Hb = WSP(unsigned char, WS_A28) + (size_t)g * A2_ROWS * 768 + 512 + dir * 128 + p;
    float hr = 0.f, hi = 0.f;
    for (int c = 0; c < 8; ++c) { const int row = A2_LAT + b * 8 + (dir == 0 ? c : 7 - c);
        const float sr = Sb[(size_t)row * 256], si = Sb[(size_t)row * 256 + 64];
        const float t = lr * hr - li * hi + sr; hi = lr * hi + li * hr + si; hr = t; }
    for (int c0 = 0; c0 < 128; c0 += 32) {
        float sr[32], si[32];
#pragma unroll
        for (int q = 0; q < 32; ++q) { const int c = c0 + q; const int row = b * 128 + (dir == 0 ? c : 127 - c); sr[q] = Sb[(size_t)row * 256]; si[q] = Sb[(size_t)row * 256 + 64]; }
#pragma unroll
        for (int q = 0; q < 32; ++q) { const int c = c0 + q; const int row = b * 128 + (dir == 0 ? c : 127 - c);
            { const int w = __builtin_amdgcn_cvt_pk_fp8_f32(hr, hi, 0, false); Hb[(size_t)row * 768] = (unsigned char)(w & 0xff); Hb[(size_t)row * 768 + 64] = (unsigned char)((w >> 8) & 0xff); }
            const float t = lr * hr - li * hi + sr[q]; hi = lr * hi + li * hr + si[q]; hr = t; }
    }
}

constexpr int ATT_NT = KV / 64;
constexpr float ATT_PBIAS = 44.f;
constexpr int ATT_SLOT = 8192;
constexpr int ATT_VB = 8 * ATT_SLOT;
constexpr int ATT_W = 3, ATT_PK = ATT_W + 2, ATT_PVD = ATT_W + 1;
typedef int v8i __attribute__((ext_vector_type(8)));
typedef int v4i __attribute__((ext_vector_type(4)));
__device__ __forceinline__ void attn_phase(Frame& F) {
    const int lane = F.lane, wid = F.wave, cmap = wid >> 2, qs = wid & 3, r32 = lane & 31, hh = lane >> 5;
    LAS unsigned char* lds = F.lds;
    const unsigned char* Q8 = WSP(unsigned char, WS_Q); const unsigned char* K8 = WSP(unsigned char, WS_K); const unsigned char* V8 = WSP(unsigned char, WS_VT); bf16_t* AO = WSP(bf16_t, WS_AO);
    const float* misc = WSP(float, WS_MISC); const float lam = misc[0];
    LAS float* sublnL = (LAS float*)(lds + LDSCTL_OFF + 2048);
    if (F.tid < 128) sublnL[F.tid] = F.in[14][F.tid];
    __syncthreads();
    const int krow = 8 * wid + (lane >> 3), kgo = krow * 512 + (((lane & 7) ^ ((krow >> 1) & 7)) * 16);
    const int vrow = 16 * wid + (lane >> 2), vgo = vrow * KV + (((lane & 3) ^ ((vrow >> 2) & 3)) * 16);
    const int ldw = wid * 1024;
    const int kp = 32 * ((r32 >> 2) & 1) + 4 * (r32 >> 3) + (r32 & 3), swk = (kp >> 1) & 7, swv = (r32 >> 2) & 3;
    const int koff0 = kp * 128 + (((4 * cmap + 2 * hh) ^ swk) * 16), koff1 = kp * 128 + (((4 * cmap + 2 * hh + 1) ^ swk) * 16);
    const int voff0 = ATT_VB + r32 * 64 + (((2 * hh) ^ swv) * 16), voff1 = ATT_VB + r32 * 64 + (((2 * hh + 1) ^ swv) * 16);
    LAS float* Lf = (LAS float*)lds;
    int sc_one = 0x7f7f7f7f, sc_q = 0x7d7d7d7d, sc_v = 0x7c7c7c7c;
    f32x16 cbias;
#pragma unroll
    for (int r = 0; r < 16; ++r) cbias[r] = ATT_PBIAS;
    asm volatile("" : "+v"(cbias));
    asm volatile("" : "+v"(sc_one), "+v"(sc_q), "+v"(sc_v));
    const int selw = (((lane & 15) == 0 || (lane & 15) == 8) && !((lane >> 4) & 1)) || (((lane & 15) == 4 || (lane & 15) == 12) && ((lane >> 4) & 1)) ? 0x38383838 : 0;
    v8i ones = {selw, selw, selw, selw, selw, selw, selw, selw};
    asm volatile("" : "+v"(ones));
    if (cmap == 1) __builtin_amdgcn_s_setprio(1);
#define ATT_DMA(gp, off) __builtin_amdgcn_global_load_lds((const unsigned*)(gp), (LAS unsigned*)(lds + (off) + ldw), 16, 0, 0)
#define ATT_LDK(dst, sb, blk) do { dst.lo = *(const LAS v4i*)(lds + (sb) + koff0 + (blk) * 2048); dst.hi = *(const LAS v4i*)(lds + (sb) + koff1 + (blk) * 2048); } while (0)
#define ATT_LDV(dst, sb, d) do { dst.lo = *(const LAS v4i*)(lds + (sb) + voff0 + (d) * 2048); dst.hi = *(const LAS v4i*)(lds + (sb) + voff1 + (d) * 2048); } while (0)
#define ATT_QK(dst, kfr) asm volatile("v_mfma_scale_f32_32x32x64_f8f6f4 %0, %1, %2, %3, %4, %5 op_sel_hi:[0,0,0]" : "=&v"(dst) : "v"(kfr), "v"(Qf), "v"(cbias), "v"(sc_one), "v"(sc_q))
#define ATT_PV(acc, vfr, Pc) asm volatile("v_mfma_scale_f32_32x32x64_f8f6f4 %0, %1, %2, %0, %3, %4 op_sel_hi:[0,0,0] blgp:1" : "+v"(acc) : "v"(vfr), "v"(Pc), "v"(sc_v), "v"(sc_one))
#define ATT_PL(Pc) asm volatile("v_mfma_scale_f32_16x16x128_f8f6f4 %0, %1, %2, %0, %3, %3 op_sel_hi:[0,0,0] blgp:1" : "+v"(L) : "v"(ones), "v"(Pc), "v"(sc_one))
#define ATT_EXP8(S, base) do { } while (0)
#define ATT_PK4(old, S, i) (int)__builtin_amdgcn_cvt_pk_u8_f32(S[(i) + 3], 3, __builtin_amdgcn_cvt_pk_u8_f32(S[(i) + 2], 2, __builtin_amdgcn_cvt_pk_u8_f32(S[(i) + 1], 1, __builtin_amdgcn_cvt_pk_u8_f32(S[i], 0, (unsigned)(old)))))
#define ATT_PACK0(Pn) do { Pn[0] = ATT_PK4(Pn[0], sc0, 0); Pn[1] = ATT_PK4(Pn[1], sc0, 4); Pn[2] = ATT_PK4(Pn[2], sc0, 8); Pn[3] = ATT_PK4(Pn[3], sc0, 12); } while (0)
#define ATT_PACK1(Pn) do { Pn[4] = ATT_PK4(Pn[4], sc1, 0); Pn[5] = ATT_PK4(Pn[5], sc1, 4); Pn[6] = ATT_PK4(Pn[6], sc1, 8); Pn[7] = ATT_PK4(Pn[7], sc1, 12); } while (0)
#define SB() __builtin_amdgcn_sched_barrier(0)
    int it = 0;
    for (;; ++it) {
        const int unit = it * F.G + F.vcu; if (unit >= NB * 4 * 32) break;
        const int b = unit >> 7, h = (unit >> 5) & 3, qb = unit & 31;
        size_t qrow = (size_t)b * SEQ + qb * 128 + qs * 32 + r32;
        const unsigned char* Kg = K8 + (size_t)b * KV * 512 + h * 128; const unsigned char* Vg = V8 + (size_t)(b * 4 + h) * 128 * KV;
#pragma unroll
        for (int j = 0; j < ATT_PK; ++j) ATT_DMA(Kg + j * (64 * 512) + kgo, j * ATT_SLOT);
#pragma unroll
        for (int j = 0; j < ATT_PVD; ++j) ATT_DMA(Vg + j * 64 + vgo, ATT_VB + j * ATT_SLOT);
        v8i Qf; { const unsigned char* qp = Q8 + qrow * 512 + h * 128 + cmap * 64 + hh * 32; Qf.lo = *(const v4i*)qp; Qf.hi = *(const v4i*)(qp + 16); }
        asm volatile("s_waitcnt vmcnt(0)\n\ts_barrier" ::: "memory");
        v8i kf0, kf1, vf0, vf1, vf2, vf3;
        ATT_LDK(kf0, 0, 0); ATT_LDK(kf1, 0, 1);
        f32x16 O[4];
#pragma unroll
        for (int d = 0; d < 4; ++d)
#pragma unroll
            for (int r = 0; r < 16; ++r) O[d][r] = 0.f;
        f32x4 L = {0.f, 0.f, 0.f, 0.f};
        f32x16 sc0, sc1; v8i Pv = {0, 0, 0, 0, 0, 0, 0, 0};
        ATT_DMA(Kg + (size_t)ATT_PK * (64 * 512) + kgo, (ATT_PK & 7) * ATT_SLOT); ATT_DMA(Vg + ATT_PVD * 64 + vgo, ATT_VB + ATT_PVD * ATT_SLOT);
        asm volatile("s_waitcnt lgkmcnt(0)" ::: "memory");
        ATT_QK(sc0, kf0); ATT_QK(sc1, kf1);
        asm volatile("s_nop 15\n\ts_nop 15\n\ts_nop 15" ::: "memory"); SB();
        ATT_LDK(kf0, ATT_SLOT, 0); ATT_LDK(kf1, ATT_SLOT, 1);
        ATT_LDV(vf0, 0, 0); ATT_LDV(vf1, 0, 1); ATT_LDV(vf2, 0, 2); ATT_LDV(vf3, 0, 3);
        ATT_EXP8(sc0, 0); ATT_EXP8(sc0, 8); ATT_EXP8(sc1, 0); ATT_EXP8(sc1, 8);
        ATT_PACK0(Pv); ATT_PACK1(Pv); SB();
        asm volatile("s_waitcnt lgkmcnt(0)" ::: "memory");
        ATT_QK(sc0, kf0); ATT_QK(sc1, kf1);
        asm volatile("s_waitcnt vmcnt(%0) lgkmcnt(0)\n\ts_barrier" :: "n"(2 * ATT_W) : "memory");
#define ATT_TILE(t_, BAR) do { \
            const int tk = (t_) + ATT_PK < ATT_NT ? (t_) + ATT_PK : ATT_NT - 1, tv = (t_) + ATT_PVD < ATT_NT ? (t_) + ATT_PVD : ATT_NT - 1; \
            const int ks_wr = (((t_) + ATT_PK) & 7) * ATT_SLOT, ks_rd = (((t_) + 1) & 7) * ATT_SLOT, vs_rd = ((t_) & 7) * ATT_SLOT, vs_wr = (((t_) + ATT_PVD) & 7) * ATT_SLOT; \
            ATT_DMA(Kg + (size_t)tk * (64 * 512) + kgo, ks_wr); ATT_DMA(Vg + tv * 64 + vgo, ATT_VB + vs_wr); SB(); \
            ATT_PV(O[0], vf0, Pv); SB(); \
            ATT_LDV(vf0, vs_rd, 0); ATT_LDK(kf0, ks_rd, 0); SB(); \
            ATT_PV(O[1], vf1, Pv); SB(); \
            ATT_LDV(vf1, vs_rd, 1); ATT_LDK(kf1, ks_rd, 1); SB(); \
            ATT_PV(O[2], vf2, Pv); SB(); \
            ATT_LDV(vf2, vs_rd, 2); SB(); \
            ATT_PV(O[3], vf3, Pv); ATT_PL(Pv); SB(); \
            ATT_PACK0(Pv); SB();                      \
            ATT_QK(sc0, kf0); SB(); \
            ATT_LDV(vf3, vs_rd, 3); ATT_PACK1(Pv); SB(); \
            ATT_QK(sc1, kf1); \
            if (BAR) asm volatile("s_waitcnt vmcnt(%0) lgkmcnt(0)\n\ts_barrier" :: "n"(2 * ATT_W - 2) : "memory"); } while (0)
#pragma unroll 1
        for (int t = 1; t < ATT_NT - 1; t += 2) { ATT_TILE(t, 0); ATT_TILE(t + 1, 1); }
        ATT_TILE(ATT_NT - 1, 1);
        ATT_PV(O[0], vf0, Pv); ATT_PV(O[1], vf1, Pv); ATT_PV(O[2], vf2, Pv); ATT_PV(O[3], vf3, Pv); ATT_PL(Pv);
        asm volatile("s_nop 15\n\ts_nop 15\n\ts_waitcnt vmcnt(0)\n\ts_barrier" ::: "memory");
        { int r32o = F.lane & 31; asm volatile("" : "+v"(r32o)); qrow = (size_t)b * SEQ + qb * 128 + qs * 32 + r32o; }
        const int tr_gw = F.vcu * 8 + F.wave, tr_ngw = F.G * 8, tr_i0 = NTR_NONEXP + (2 * it) * tr_ngw + tr_gw, tr_i1 = tr_i0 + tr_ngw;
        const bool tr_has = tr_i0 < NTR_ITEMS, tr_two = tr_i1 < NTR_ITEMS;
        const TrItem tr_t0 = tr_decode(F.in, F.ws, tr_has ? tr_i0 : NTR_NONEXP), tr_t1 = tr_decode(F.in, F.ws, tr_two ? tr_i1 : NTR_NONEXP);
        f32x4 tr_v0[8], tr_v1[8];
        tr_load(tr_t0, lane, tr_v0); tr_load(tr_t1, lane, tr_v1);
        const float inv = 1.f / L[0];
        LAS float* SS = Lf + 16384;
#define ATT_SEND(d, slot) do { _Pragma("unroll") for (int r = 0; r < 16; ++r) Lf[(slot) * 8192 + ((qs * 2 + ((d) & 1)) * 16 + r) * 64 + lane] = O[d][r] * inv; } while (0)
        if (cmap == 0) { ATT_SEND(2, 1); ATT_SEND(3, 1); } else { ATT_SEND(0, 0); ATT_SEND(1, 0); }
        __syncthreads();
        float ss = 0.f;
#define ATT_COMB0(d) do { _Pragma("unroll") for (int r = 0; r < 16; ++r) { const float o = O[d][r] * inv - lam * Lf[((qs * 2 + ((d) & 1)) * 16 + r) * 64 + lane]; O[d][r] = o; ss += o * o; } } while (0)
#define ATT_COMB1(d) do { _Pragma("unroll") for (int r = 0; r < 16; ++r) { const float o = Lf[8192 + ((qs * 2 + ((d) & 1)) * 16 + r) * 64 + lane] - lam * (O[d][r] * inv); O[d][r] = o; ss += o * o; } } while (0)
        if (cmap == 0) { ATT_COMB0(0); ATT_COMB0(1); } else { ATT_COMB1(2); ATT_COMB1(3); }
        ss += __shfl_xor(ss, 32);
        if (hh == 0) SS[(cmap * 4 + qs) * 32 + r32] = ss;
        __syncthreads();
        ss += SS[((1 - cmap) * 4 + qs) * 32 + r32];
        const float rn = (1.f - LAM_INIT) / sqrtf(ss * (1.f / 128.f) + RMS_EPS);
#define ATT_STORE(d) do { _Pragma("unroll") for (int gp = 0; gp < 2; ++gp) { \
            const f32x4 sge = *(const LAS f32x4*)(sublnL + 32 * (d) + 16 * gp + 4 * hh), sgo = *(const LAS f32x4*)(sublnL + 32 * (d) + 16 * gp + 8 + 4 * hh); \
            const unsigned ex = cvt_pk_bf16(O[d][8 * gp] * rn * sge[0], O[d][8 * gp + 1] * rn * sge[1]), ey = cvt_pk_bf16(O[d][8 * gp + 2] * rn * sge[2], O[d][8 * gp + 3] * rn * sge[3]); \
            const unsigned ox = cvt_pk_bf16(O[d][8 * gp + 4] * rn * sgo[0], O[d][8 * gp + 5] * rn * sgo[1]), oy = cvt_pk_bf16(O[d][8 * gp + 6] * rn * sgo[2], O[d][8 * gp + 7] * rn * sgo[3]); \
            const u32x2 rx = __builtin_amdgcn_permlane32_swap(ex, ox, false, false), ry = __builtin_amdgcn_permlane32_swap(ey, oy, false, false); \
            u32x4 w; w.x = rx[0]; w.y = ry[0]; w.z = rx[1]; w.w = ry[1]; \
            *(u32x4*)(AO + qrow * 1024 + h * 128 + 32 * (d) + 8 * (2 * gp + hh)) = w; } } while (0)
        if (cmap == 0) { ATT_STORE(0); ATT_STORE(1); } else { ATT_STORE(2); ATT_STORE(3); }
#undef ATT_SEND
#undef ATT_COMB0
#undef ATT_COMB1
#undef ATT_STORE
        __syncthreads();
        { LAS float* scr = (LAS float*)F.lds + F.wave * 4096;
          if (tr_has) tr_store(tr_t0, lane, tr_v0, scr);
          if (tr_two) tr_store(tr_t1, lane, tr_v1, scr); }
        __syncthreads();
    }
    for (; it < 8; ++it) tr_expert_slice(F, it);
    __builtin_amdgcn_s_setprio(0);
#undef ATT_DMA
#undef ATT_LDK
#undef ATT_LDV
#undef ATT_QK
#undef ATT_PV
#undef ATT_EXP8
#undef ATT_PK4
#undef ATT_SUM8
#undef ATT_PACK0
#undef ATT_PACK1
#undef ATT_TILE
#undef ATT_PL
#undef SB
}

constexpr int NPHASE = 15;
__device__ __forceinline__ void moe_prefix(Frame& F) {
    LAS int* toff = (LAS int*)(F.lds + LDSCTL_OFF);
    const int* gcnt = (const int*)(F.ws + WS_CTL) + CW_CNT;
    __syncthreads();
    if (F.tid == 0) { int s = 0; for (int i = 0; i < 64; ++i) { toff[i] = s; s += (gcnt[i] + 255) >> 8; } toff[64] = s; }
    if (F.tid == 64) { LAS int* toff2 = toff + 128; LAS int* cn2 = toff + 512; const int* gcnt2 = gcnt + 64; int s = 0; for (int i = 0; i < NPAIR; ++i) { const int n = gcnt2[i]; cn2[i] = n; toff2[i] = s; s += (n + 255) >> 8; } toff2[NPAIR] = s; }
    __syncthreads();
}
__global__ void __launch_bounds__(512, 2) fwd_kernel(Args args) {
    extern __shared__ __attribute__((aligned(16))) unsigned char lds_raw[];
    Frame F;
    F.lds = (LAS unsigned char*)lds_raw;
    F.tid = threadIdx.x; F.lane = F.tid & 63; F.wave = __builtin_amdgcn_readfirstlane(F.tid >> 6);
    F.G = gridDim.x; { const int bx = blockIdx.x; F.vcu = (F.G % 8 == 0) ? (bx % 8) * (F.G / 8) + bx / 8 : bx; }
    F.in = args.in; F.out = args.out; F.ws = args.ws;
    volatile LAS unsigned* MISC = (volatile LAS unsigned*)(F.lds + MISC_OFF);
    for (int u = F.tid; u < (LDS_BYTES - LDSCTL_OFF) / 4; u += 512) ((LAS unsigned*)(F.lds + LDSCTL_OFF))[u] = 0u;
    __syncthreads();
    const int lo = args.ph_lo, hi = args.ph_hi;
    XcdBarrier bar; bar.bar = (unsigned*)(F.ws + WS_CTL) + CW_BAR; bar.x = 0; bar.st = nullptr;
    if (hi - lo > 1) bar = xcd_barrier_post((unsigned*)(F.ws + WS_CTL) + CW_BAR, MISC + 8);
#define IN(k) (lo <= (k) && (k) < hi)
#define SEAM(k) do { if (IN(k) && IN((k) + 1)) xcd_barrier(bar); } while (0)
#define WSB_ ((const char*)F.ws)
#define MOD_ WSP(float, WS_MOD)
#define GCNT_ ((int*)(F.ws + WS_CTL) + CW_CNT)
#define LTOK_ WSP(int, WS_LTOK)
#define LWP_ WSP(float, WS_LW)
#define TOFF_ ((LAS int*)(F.lds + LDSCTL_OFF))

    if (IN(0)) { p0_prologue(F); } SEAM(0);
    if (IN(1)) { norm_mod_rows(F, F.in[0], T, F.in[2], TC, F.in[6], MOD_, 0, 1024, WSP(unsigned char, WS_XN)); } SEAM(1);
    if (IN(2)) { pg8::Gemm g{512, 512, 512};         SchedInProj S{WSB_ + WS_XN, WSB_ + WS_WQKU, WSB_ + WS_WV, F.G, F.vcu};
        EpiInProj E{WSP(unsigned char, WS_Q), WSP(unsigned char, WS_K), WSP(bf16_t, WS_A2), WSP(unsigned char, WS_A28), WSP(unsigned char, WS_VT), F.in[8], F.in[9], WSP(float, WS_MISC) + 64};
        pg8::gemm_phase<EpiInProj, SchedInProj, true, true>(F.lds, g, S, E);
        { const int full = 2144 / F.G, rem = 2144 % F.G;
          if (F.vcu >= rem && rem > 0) s5_matrix_items(F, F.vcu - rem, F.G - rem); else if (rem == 0) s5_matrix_items(F, F.vcu, F.G); (void)full; } } SEAM(2);
    if (IN(4)) {
        { pg8::Gemm g{A2_LD, 512, 512}; SchedS5 S{WSB_ + WS_A2, WSB_ + WS_S5W1, 512, 256, 9, 1, 288, F.G, F.vcu, (size_t)A2_ROWS * A2_LD * 2}; EpiS5State E{WSP(float, WS_SB)};
          pg8::gemm_phase<EpiS5State, SchedS5, true>(F.lds, g, S, E); }
        attn_phase(F); } SEAM(4);
    if (IN(5)) { s5_scan_phase(F); } SEAM(5);
    if (IN(7)) { pg8::Gemm g{384, 384, 384};        SchedS5 S{WSB_ + WS_A28, WSB_ + WS_S5W2, 384, 512, 8, 2, 512, F.G, F.vcu, (size_t)A2_ROWS * 768}; EpiS5Out E{WSP(unsigned char, WS_YG)};
        pg8::gemm_phase<EpiS5Out, SchedS5, true, true>(F.lds, g, S, E); } SEAM(7);
    if (IN(8)) { pg8::Gemm g{256, 256, 256};        SchedGrid S{WSB_ + WS_YG, WSB_ + WS_WGLU, 256, 2, 512, F.G, F.vcu}; EpiGlu E{WSP(unsigned char, WS_YG), F.in[24], WSP(bf16_t, WS_AO)};
        pg8::gemm_phase<EpiGlu, SchedGrid, true, true>(F.lds, g, S, E); } SEAM(8);
    if (IN(9)) { pg8::Gemm g{1024, 1024, 1024}; SchedGrid S{WSB_ + WS_AO, WSB_ + WS_WOUT, 1024, 4, 1024, F.G, F.vcu}; EpiOut E{F.in[0], MOD_, WSP(bf16_t, WS_X1B)};
        pg8::gemm_phase<EpiOut, SchedGrid, true>(F.lds, g, S, E); } SEAM(9);
    if (IN(10)) { norm2_router_phase(F, WSP(bf16_t, WS_X1B), F.in[26], MOD_, WSP(bf16_t, WS_T8), WSP(bf16_t, WS_WR), F.in[28], F.in[30], GCNT_, LTOK_, LWP_, GCNT_ + 64, WSP(int, WS_LROW), WSP(int, WS_PTOK)); } SEAM(10);
    if (IN(12)) { moe_prefix(F); pg8::Gemm g{512, 512, 512};
        SchedMoe S{WSB_ + WS_T8, WSB_ + WS_WGU, TOFF_, GCNT_, LTOK_, 0, 64, 4, 512, 1024, 1, F.G, F.vcu}; EpiGateUp E{F.ws + WS_H, GCNT_, LWP_, WSP(int, WS_LROW), TOFF_ + 128, F.ws + WS_TRASH};
        pg8::gemm_phase<EpiGateUp, SchedMoe, true, true>(F.lds, g, S, E); } SEAM(12);
    if (IN(13)) { moe_prefix(F); pg8::Gemm g{512, 256, 512};
        SchedPair S{WSB_ + WS_H, WSB_ + WS_WD, TOFF_ + 128, F.G, F.vcu, TOFF_ + 512}; EpiDown2 E{GCNT_ + 64, WSP(int, WS_PTOK), MOD_, WSP(bf16_t, WS_X1B), F.out, F.ws + WS_TRASH};
        pg8::gemm_phase<EpiDown2, SchedPair, true, true, true>(F.lds, g, S, E); }
#undef IN
#undef SEAM
#undef WSB_
#undef MOD_
#undef GCNT_
#undef LTOK_
#undef LWP_
#undef TOFF_
}

extern "C" void kernel_launch(void* const* d_in, const int* in_sizes, int n_in, void* d_out, int out_size, void* d_ws, size_t ws_size, hipStream_t stream) {
    static int grid = 0;
    if (grid == 0) {
        if (n_in != 34 || out_size != T * DM || ws_size < WS_END) { fprintf(stderr, "kernel_launch: unexpected shapes (n_in %d out %d ws %zu)\n", n_in, out_size, ws_size); grid = -1; return; }
        int dev = 0, cus = 0, per_cu = 0;
        if (hipGetDevice(&dev) != hipSuccess || hipDeviceGetAttribute(&cus, hipDeviceAttributeMultiprocessorCount, dev) != hipSuccess) { grid = -1; return; }
        if (hipFuncSetAttribute((const void*)fwd_kernel, hipFuncAttributeMaxDynamicSharedMemorySize, LDS_BYTES) != hipSuccess) { fprintf(stderr, "kernel_launch: hipFuncSetAttribute failed\n"); grid = -1; return; }
        if (hipOccupancyMaxActiveBlocksPerMultiprocessor(&per_cu, (const void*)fwd_kernel, 512, LDS_BYTES) != hipSuccess || per_cu < 1) { fprintf(stderr, "kernel_launch: occupancy query says %d\n", per_cu); }
        (void)hipGetLastError();
        grid = cus;
    }
    if (grid < 0) return;
    (void)hipMemsetAsync((char*)d_ws + WS_CTL, 0, CTL_ZERO_BYTES, stream);
    Args a{};
    for (int i = 0; i < 34; ++i) a.in[i] = (const float*)d_in[i];
    a.out = (float*)d_out; a.ws = (unsigned char*)d_ws;
#if MK_ONE_LAUNCH
    a.ph_lo = 0; a.ph_hi = NPHASE;
    hipLaunchKernelGGL(fwd_kernel, dim3(grid), dim3(512), LDS_BYTES, stream, a);
#else
    for (int k = 0; k < NPHASE; ++k) { a.ph_lo = k; a.ph_hi = k + 1; hipLaunchKernelGGL(fwd_kernel, dim3(grid), dim3(512), LDS_BYTES, stream, a); }
#endif
}
```

```cpp
#include <hip/hip_runtime.h>
#include <cstdio>
#include <cstdint>

#ifndef MK_ONE_LAUNCH
#define MK_ONE_LAUNCH 1
#endif

#define LAS __attribute__((address_space(3)))
#define GAS __attribute__((address_space(1)))
typedef unsigned short bf16_t;
typedef short bf16x8 __attribute__((ext_vector_type(8)));
typedef float f32x2 __attribute__((ext_vector_type(2)));
typedef float f32x4 __attribute__((ext_vector_type(4)));
typedef float f32x16 __attribute__((ext_vector_type(16)));
typedef unsigned u32x2 __attribute__((ext_vector_type(2)));
typedef unsigned u32x4 __attribute__((ext_vector_type(4)));

constexpr int T = 65536, TC = 4096, MT = T + TC, DM = 1024, NB = 16, SEQ = 4096, CTX = 256, KV = SEQ + CTX;
constexpr int NE = 32, FF = 512;
constexpr int SG = 32, SL = 32, A2_ROWS = 2304, A2_LD = 768, A2_LAT = 2048;
constexpr float RMS_EPS = 1e-6f;
constexpr float LAM_INIT = 0.2f;
constexpr float C2 = 0.125f * 1.4426950408889634f;
constexpr int LISTCAP = 65536;

constexpr size_t MiB = 1u << 20;
constexpr size_t WS_CTL = 0, CTL_ZERO_BYTES = 1 * MiB;
constexpr size_t WS_MOD = 1 * MiB;
constexpr size_t WS_MISC = 2 * MiB;
constexpr size_t WS_WQKU = 3 * MiB;
constexpr size_t WS_WV = 6 * MiB;
constexpr size_t WS_WGLU = 7 * MiB;
constexpr size_t WS_WR = 7 * MiB + 512 * 1024;
constexpr size_t WS_WOUT = 8 * MiB;
constexpr size_t WS_S5W1 = 10 * MiB;
constexpr size_t WS_S5W2 = 18 * MiB;
constexpr size_t WS_WGU = 42 * MiB;
constexpr size_t WS_WD = 106 * MiB;
constexpr size_t WS_LTOK = 138 * MiB;
constexpr size_t WS_LW = 154 * MiB;
constexpr size_t WS_XN = 170 * MiB;
constexpr size_t WS_A28 = 240 * MiB;
constexpr size_t WS_Q = 306 * MiB;
constexpr size_t WS_K = 370 * MiB;
constexpr size_t WS_VT = 438 * MiB;
constexpr size_t WS_H = 306 * MiB;
constexpr size_t WS_A2 = 506 * MiB;
constexpr size_t WS_SB = 614 * MiB;
constexpr size_t WS_YG = 686 * MiB;
constexpr size_t WS_AO = 750 * MiB;
constexpr size_t WS_X1B = 506 * MiB;
constexpr size_t WS_T8 = 170 * MiB;
constexpr size_t WS_LROW = 880 * MiB;
constexpr size_t WS_PTOK = 896 * MiB;
constexpr size_t WS_TRASH = 1008 * MiB;
constexpr size_t WS_END = 1009 * MiB;

constexpr int CW_TMO = 0;
constexpr int CW_BAR = 4096;
constexpr int CW_CNT = 16384;
constexpr int CW_CNT2 = 16384 + 64;
constexpr int NPAIR = 112;

constexpr int RING_BYTES = 131072;
constexpr int LDSCTL_OFF = RING_BYTES, MISC_OFF = LDSCTL_OFF + 1024;
constexpr int LDS_BYTES = 147456;

#define RLX_AGENT __ATOMIC_RELAXED, __HIP_MEMORY_SCOPE_AGENT

__device__ __forceinline__ unsigned cvt_pk_bf16(float lo, float hi) { unsigned r; asm volatile("v_cvt_pk_bf16_f32 %0, %1, %2" : "=v"(r) : "v"(lo), "v"(hi)); return r; }
__device__ __forceinline__ float bf_lo(unsigned u) { return __builtin_bit_cast(float, u << 16); }
__device__ __forceinline__ float bf_hi(unsigned u) { return __builtin_bit_cast(float, u & 0xffff0000u); }
__device__ __forceinline__ u32x2 pack8_fp8(float a0, float a1, float a2, float a3, float a4, float a5, float a6, float a7) { int w0 = 0, w1 = 0;
    w0 = __builtin_amdgcn_cvt_pk_fp8_f32(a0, a1, w0, false); w0 = __builtin_amdgcn_cvt_pk_fp8_f32(a2, a3, w0, true); w1 = __builtin_amdgcn_cvt_pk_fp8_f32(a4, a5, w1, false); w1 = __builtin_amdgcn_cvt_pk_fp8_f32(a6, a7, w1, true);
    u32x2 o; o.x = (unsigned)w0; o.y = (unsigned)w1; return o; }
__device__ __forceinline__ float wave_sum(float v) {
#pragma unroll
    for (int o = 1; o < 64; o <<= 1) v += __shfl_xor(v, o);
    return v;
}
__device__ __forceinline__ float fast_rcp(float x) { return __builtin_amdgcn_rcpf(x); }
__device__ __forceinline__ float sigmoidf_(float x) { return fast_rcp(1.f + __builtin_amdgcn_exp2f(-1.4426950408889634f * x)); }

namespace pg8 {
constexpr int BM = 256, BK = 64, HALF = 128, HTB = HALF * BK * 2, STAGE_BYTES = 8 * HTB;
template <bool FL> __host__ __device__ __forceinline__ int lds_byte(int r, int c) {
    if (FL) return (r >> 3) * 1024 + (r & 7) * 128 + (((c >> 3) ^ ((r >> 1) & 7)) * 16) + (c & 7) * 2;
    const int st = (r >> 4) * 2 + (c >> 5), rr = r & 15, cc = c & 31, ob = rr * 64 + cc * 2; return st * 1024 + (ob ^ (((ob >> 9) & 1) << 5)); }
template <bool FL> __host__ __device__ __forceinline__ void stage_rc(int b, int& R, int& C) {
    if (FL) { const int st = b / 1024, sb = b % 1024; R = 8 * st + (sb >> 7); C = (((sb >> 4) & 7) ^ ((R >> 1) & 7)) * 8; return; }
    const int st = b / 1024, sb = b % 1024, swz = sb ^ (((sb >> 9) & 1) << 5); R = (st >> 1) * 16 + swz / 64; C = (st & 1) * 32 + (swz % 64) / 2; }
__host__ __device__ __forceinline__ int perm32(int rho) { const int n = rho >> 4, i = rho & 15; return 8 * (i >> 2) + 4 * n + (i & 3); }

struct Unit { int pm, pn, grp, aux; };
template <class E> struct epi_nst2 { static constexpr bool v = false; static constexpr int n = 0; };
template <class E> struct epi_rows { static constexpr bool v = false; static constexpr int nw = 0, off = 0, stride = 0; };
template <class S> struct sched_gather { static constexpr bool v = false; };
struct Gemm { int lda, ldb, K; };

typedef int v8i_t __attribute__((ext_vector_type(8)));
typedef int v4i_t __attribute__((ext_vector_type(4)));
template <class Epi, class Sched, bool ALIGN_EPI, bool FP8 = false, bool STACKB = false>
__device__ __forceinline__ void gemm_phase(LAS unsigned char* lds, const Gemm g, const Sched& S, const Epi& E) {
    const int tid = threadIdx.x, wid = __builtin_amdgcn_readfirstlane(tid >> 6), lane = tid & 63, wr = wid >> 2, wc = wid & 3, fr = lane & 15, fq = lane >> 4;
    const int K = g.K, nt = K / BK;
    int RR[2], CC[2]; unsigned voffB[2];
#pragma unroll
    for (int i = 0; i < 2; ++i) { stage_rc<FP8>(tid * 16 + i * 8192, RR[i], CC[i]); const int Rb = Epi::PERM ? ((RR[i] & ~31) + perm32(RR[i] & 31)) : RR[i];
        voffB[i] = (unsigned)(Rb * g.ldb + CC[i]) * 2u; }
    const size_t kstep = (size_t)(BK * 2);
    const size_t hstepB = (size_t)HALF * g.ldb * 2;
    const unsigned ldsw = (unsigned)wid * 1024u;
    const int aoff = lds_byte<FP8>(wr * 64 + fr, fq * 8), boff = lds_byte<FP8>(wc * 32 + fr, fq * 8);
    const int aoff2 = lds_byte<FP8>(wr * 64 + fr, fq * 8 + 32), boff2 = lds_byte<FP8>(wc * 32 + fr, fq * 8 + 32);
#define PG8_SA(b, h) (((b) * 2 + (h)) * HTB)
#define PG8_SB(b, h) ((4 + (b) * 2 + (h)) * HTB)
#define PG8_STAGE_B(bufoff, gbase) do { _Pragma("unroll") for (int _i = 0; _i < 2; ++_i) \
        __builtin_amdgcn_global_load_lds((const unsigned*)((const char*)(gbase) + voffB[_i]), (LAS unsigned*)(lds + (bufoff) + ldsw + _i * 8192), 16, 0, 0); } while (0)
#define PG8_STAGE_A(bufoff, gbase, V0, V1) do { \
        __builtin_amdgcn_global_load_lds((const unsigned*)((const char*)(gbase) + (V0)), (LAS unsigned*)(lds + (bufoff) + ldsw), 16, 0, 0); \
        __builtin_amdgcn_global_load_lds((const unsigned*)((const char*)(gbase) + (V1)), (LAS unsigned*)(lds + (bufoff) + ldsw + 8192), 16, 0, 0); } while (0)
#define PG8_LDA(dst, b, h) do { if constexpr (FP8) { _Pragma("unroll") for (int m = 0; m < 4; ++m) { dst##8[m].lo = *(const LAS v4i_t*)(lds + PG8_SA(b, h) + aoff + m * 2048); dst##8[m].hi = *(const LAS v4i_t*)(lds + PG8_SA(b, h) + aoff2 + m * 2048); } } \
        else { _Pragma("unroll") for (int m = 0; m < 4; ++m) _Pragma("unroll") for (int k = 0; k < 2; ++k) dst[m][k] = *(const LAS bf16x8*)(lds + PG8_SA(b, h) + aoff + m * 2048 + k * 1024); } } while (0)
#define PG8_LDB(dst, b, h) do { if constexpr (FP8) { _Pragma("unroll") for (int n = 0; n < 2; ++n) { dst##8[n].lo = *(const LAS v4i_t*)(lds + PG8_SB(b, h) + boff + n * 2048); dst##8[n].hi = *(const LAS v4i_t*)(lds + PG8_SB(b, h) + boff2 + n * 2048); } } \
        else { _Pragma("unroll") for (int n = 0; n < 2; ++n) _Pragma("unroll") for (int k = 0; k < 2; ++k) dst[n][k] = *(const LAS bf16x8*)(lds + PG8_SB(b, h) + boff + n * 2048 + k * 1024); } } while (0)
#define PG8_MMA(ai, bj, At, Bt) do { __builtin_amdgcn_s_setprio(1); \
        if constexpr (FP8) { _Pragma("unroll") for (int m = 0; m < 4; ++m) _Pragma("unroll") for (int n = 0; n < 2; ++n) \
            asm volatile("v_mfma_scale_f32_16x16x128_f8f6f4 %0, %1, %2, %0, %3, %4 op_sel_hi:[0,0,0]" : "+v"(acc[ai][bj][m][n]) : "v"(Bt##8[n]), "v"(At##8[m]), "v"(f8scale), "v"(f8scale2)); } \
              \
        else { _Pragma("unroll") for (int m = 0; m < 4; ++m) _Pragma("unroll") for (int n = 0; n < 2; ++n) _Pragma("unroll") for (int k = 0; k < 2; ++k) \
            acc[ai][bj][m][n] = __builtin_amdgcn_mfma_f32_16x16x32_bf16(Bt[n][k], At[m][k], acc[ai][bj][m][n], 0, 0, 0); } \
        __builtin_amdgcn_s_setprio(0); } while (0)
#define PG8_WAIT_V(n) asm volatile("s_waitcnt vmcnt(" #n ")" ::: "memory")
#define PG8_WAIT_V8R(relax) do { if (relax) { if (epi_nst2<Epi>::v && prev_big) asm volatile("s_waitcnt vmcnt(%0)" :: "n"(8 + (epi_nst2<Epi>::v ? epi_nst2<Epi>::n : Epi::NST)) : "memory"); \
        else asm volatile("s_waitcnt vmcnt(%0)" :: "n"(8 + Epi::NST) : "memory"); } else asm volatile("s_waitcnt vmcnt(8)" ::: "memory"); } while (0)
#define PG8_WAIT_L(n) asm volatile("s_waitcnt lgkmcnt(" #n ")" ::: "memory")
#define PG8_BAR __builtin_amdgcn_s_barrier()
#define PG8_SCHED __builtin_amdgcn_sched_barrier(0)
#define PG8_MKVO(u, v00, v01, v10, v11) do { \
        v00 = (S.arow(u, RR[0]) * (unsigned)g.lda + (unsigned)CC[0]) * 2u; v01 = (S.arow(u, RR[1]) * (unsigned)g.lda + (unsigned)CC[1]) * 2u; \
        v10 = (S.arow(u, HALF + RR[0]) * (unsigned)g.lda + (unsigned)CC[0]) * 2u; v11 = (S.arow(u, HALF + RR[1]) * (unsigned)g.lda + (unsigned)CC[1]) * 2u; } while (0)
    Unit cur, nxt; int ui = 0; bool prev_big = false;
    if (!S.next(0, cur)) return;
    f32x4 acc[2][2][4][2];
#pragma unroll
    for (int a = 0; a < 2; ++a)
#pragma unroll
        for (int b = 0; b < 2; ++b)
#pragma unroll
            for (int m = 0; m < 4; ++m)
#pragma unroll
                for (int n = 0; n < 2; ++n) acc[a][b][m][n] = (f32x4){0.f, 0.f, 0.f, 0.f};
    bf16x8 At[4][2], B0[2][2], B1[2][2]; v8i_t At8[4], B08[2], B18[2];
    int f8scale = 0x7f7f7f7f, f8scale2 = Epi::F8SC; asm volatile("" : "+v"(f8scale), "+v"(f8scale2));
    unsigned c00, c01, c10, c11, n00, n01, n10, n11;
    PG8_MKVO(cur, c00, c01, c10, c11);
    const char* cA = S.abase(cur); const char* cB = S.bbase(cur); const char* cB2 = cB; if constexpr (STACKB) cB2 = S.bbase2(cur);
    PG8_STAGE_B(PG8_SB(0, 0), cB); PG8_STAGE_B(PG8_SB(0, 1), cB + hstepB); PG8_STAGE_A(PG8_SA(0, 0), cA, c00, c01); PG8_STAGE_A(PG8_SA(0, 1), cA, c10, c11);
    if (wr == 1) PG8_BAR;
    PG8_WAIT_V(2); PG8_BAR;
    PG8_STAGE_B(PG8_SB(1, 0), cB + kstep); PG8_STAGE_A(PG8_SA(1, 0), cA + kstep, c00, c01); PG8_STAGE_B(PG8_SB(1, 1), cB + hstepB + kstep);
    PG8_WAIT_V(6); PG8_BAR;
    for (;;) {
        if constexpr (epi_rows<Epi>::v) { if (wid < epi_rows<Epi>::nw) E.rows_dma(cur, (LAS int*)(lds + RING_BYTES + epi_rows<Epi>::off + (ui & 1) * epi_rows<Epi>::stride), wid, lane); }
        const bool has_next = S.next(ui + 1, nxt);
        const char* nA = cA; const char* nB = cB; n00 = c00; n01 = c01; n10 = c10; n11 = c11;
        const char* nB2 = cB2;
        if (has_next) { nA = S.abase(nxt); nB = S.bbase(nxt); if constexpr (STACKB) nB2 = S.bbase2(nxt);
            if constexpr (!sched_gather<Sched>::v) PG8_MKVO(nxt, n00, n01, n10, n11);
            else { if (wid < 4) S.rows_dma(nxt, (LAS int*)(lds + RING_BYTES + 8192), wid, lane); } }
#pragma unroll 1
        for (int t = 0; t < nt; t += 2) {
            const bool last = (t == nt - 2);
            const char* a1 = cA + (size_t)(t + 1) * kstep;
            const char* a2 = last ? nA : cA + (size_t)(t + 2) * kstep;
            const char* b2 = last ? nB : ((STACKB && t + 2 >= nt / 2) ? cB2 + (size_t)(t + 2 - nt / 2) * kstep : cB + (size_t)(t + 2) * kstep);
            const char* a3 = a2 + kstep; const char* b3 = b2 + kstep;
            if constexpr (sched_gather<Sched>::v) { if (last && has_next) { const LAS int* rowl = (const LAS int*)(lds + RING_BYTES + 8192);
                n00 = ((unsigned)rowl[RR[0]] * (unsigned)g.lda + (unsigned)CC[0]) * 2u; n01 = ((unsigned)rowl[RR[1]] * (unsigned)g.lda + (unsigned)CC[1]) * 2u;
                n10 = ((unsigned)rowl[HALF + RR[0]] * (unsigned)g.lda + (unsigned)CC[0]) * 2u; n11 = ((unsigned)rowl[HALF + RR[1]] * (unsigned)g.lda + (unsigned)CC[1]) * 2u; } }
            const unsigned x00 = last ? n00 : c00, x01 = last ? n01 : c01, x10 = last ? n10 : c10, x11 = last ? n11 : c11;
            const bool relax = (Epi::NST > 0) && (t == 0) && (ui > 0);
            PG8_LDB(B0, 0, 0); PG8_LDB(B1, 0, 1); PG8_SCHED; PG8_LDA(At, 0, 0); PG8_STAGE_A(PG8_SA(1, 1), a1, c10, c11);
            PG8_WAIT_V8R(relax); PG8_WAIT_L(0); PG8_BAR; PG8_MMA(0, 0, At, B0); PG8_MMA(0, 1, At, B1); PG8_BAR; PG8_SCHED;
            PG8_LDA(At, 0, 1); PG8_STAGE_B(PG8_SB(0, 0), b2); PG8_STAGE_B(PG8_SB(0, 1), b2 + hstepB); PG8_STAGE_A(PG8_SA(0, 0), a2, x00, x01);
            PG8_WAIT_V8R(relax); PG8_WAIT_L(0); PG8_BAR; PG8_MMA(1, 0, At, B0); PG8_MMA(1, 1, At, B1); PG8_BAR; PG8_SCHED;
            PG8_LDB(B0, 1, 0); PG8_LDB(B1, 1, 1); PG8_SCHED; PG8_LDA(At, 1, 0); PG8_STAGE_A(PG8_SA(0, 1), a2, x10, x11);
            PG8_WAIT_V(8); PG8_WAIT_L(0); PG8_BAR; PG8_MMA(0, 0, At, B0); PG8_MMA(0, 1, At, B1); PG8_BAR; PG8_SCHED;
            PG8_LDA(At, 1, 1); PG8_STAGE_B(PG8_SB(1, 0), b3); PG8_STAGE_B(PG8_SB(1, 1), b3 + hstepB); PG8_STAGE_A(PG8_SA(1, 0), a3, x00, x01);
            PG8_WAIT_V(8); PG8_WAIT_L(0); PG8_BAR; PG8_MMA(1, 0, At, B0); PG8_MMA(1, 1, At, B1); PG8_BAR; PG8_SCHED;
        }
        if constexpr (ALIGN_EPI) { if (wr == 0) PG8_BAR; }
        if constexpr (FP8) asm volatile("s_nop 15\n\ts_nop 15" ::: "memory");
        if constexpr (!Epi::AFTER_DRAIN) { int fr_ = fr, fq_ = fq; asm volatile("" : "+v"(fr_), "+v"(fq_));
            if constexpr (epi_rows<Epi>::v) E(acc, cur, wr, wc, fr_, fq_, (const LAS int*)(lds + RING_BYTES + epi_rows<Epi>::off + (ui & 1) * epi_rows<Epi>::stride)); else E(acc, cur, wr, wc, fr_, fq_); }
        if (!has_next) break;
#pragma unroll
        for (int a = 0; a < 2; ++a)
#pragma unroll
            for (int b = 0; b < 2; ++b)
#pragma unroll
                for (int m = 0; m < 4; ++m)
#pragma unroll
                    for (int n = 0; n < 2; ++n) acc[a][b][m][n] = (f32x4){0.f, 0.f, 0.f, 0.f};
        if constexpr (epi_nst2<Epi>::v) prev_big = E.big(cur);
        cur = nxt; cA = nA; cB = nB; cB2 = nB2; c00 = n00; c01 = n01; c10 = n10; c11 = n11; ++ui;
        if constexpr (ALIGN_EPI) { if (wr == 1) PG8_BAR; }
    }
    PG8_WAIT_V(0);
    if constexpr (!ALIGN_EPI) { if (wr == 0) PG8_BAR; }
    PG8_BAR;
    if constexpr (Epi::AFTER_DRAIN) { E.fused(acc, cur, wr, wc, fr, fq, lds, wid, lane); }
#undef PG8_SA
#undef PG8_SB
#undef PG8_STAGE_A
#undef PG8_STAGE_B
#undef PG8_LDA
#undef PG8_LDB
#undef PG8_MMA
#undef PG8_WAIT_V
#undef PG8_WAIT_V8R
#undef PG8_WAIT_L
#undef PG8_BAR
#undef PG8_SCHED
#undef PG8_MKVO
}
}
using pg8::Unit;

#define XB_TMO      128
#define XB_XCNT(j)  (256  + 64 * (j))
#define XB_XSUB(j)  (1280 + 64 * (j))
#define XB_XGEN(j)  (2304 + 64 * (j))
#define XB_TOP      3328
#define XB_TOPGEN   3392
#define XCD_BAR_WORDS 3456
#define XB_SPIN_CAP (1u << 22)

__device__ __forceinline__ unsigned xb_ld(unsigned* p)              { return __hip_atomic_load(p, __ATOMIC_RELAXED, __HIP_MEMORY_SCOPE_AGENT); }
__device__ __forceinline__ unsigned xb_add(unsigned* p, unsigned v) { return __hip_atomic_fetch_add(p, v, __ATOMIC_RELAXED, __HIP_MEMORY_SCOPE_AGENT); }
__device__ __forceinline__ unsigned xb_xcc_id() { return (unsigned)__builtin_amdgcn_s_getreg((3 << 11) | 20) & 0xFu; }
#define XB_SPIN(cond, bar) do { unsigned _sp = 0; while (cond) { __builtin_amdgcn_s_sleep(1); \
    if ((++_sp & 255u) == 0u) { if (xb_ld(&(bar)[XB_TMO])) break; if (_sp > XB_SPIN_CAP) { atomicAdd(&(bar)[XB_TMO], 1u); break; } } } } while (0)

struct XcdBarrier { unsigned* bar; unsigned x; volatile LAS unsigned* st; };

__device__ __forceinline__ XcdBarrier xcd_barrier_post(unsigned* bar, volatile LAS unsigned* st) {
    XcdBarrier b; b.bar = bar; b.x = xb_xcc_id(); b.st = st;
    if (threadIdx.x == 0) (void)xb_add(&bar[XB_XCNT(b.x)], 1u);
    return b;
}
__device__ __forceinline__ void xcd_barrier_complete(unsigned* bar, unsigned x, unsigned& nloc, unsigned& nx) {
    const unsigned G = gridDim.x * gridDim.y * gridDim.z;
    unsigned sum, cnt, mine, sp = 0u;
    for (;;) {
        sum = 0u; cnt = 0u; mine = 0u;
#pragma unroll
        for (unsigned j = 0; j < 16; ++j) { const unsigned c = xb_ld(&bar[XB_XCNT(j)]); sum += c; cnt += (c > 0u) ? 1u : 0u; mine = (j == x) ? c : mine; }
        if (sum == G) break;
        __builtin_amdgcn_s_sleep(1);
        if ((++sp & 255u) == 0u) { if (xb_ld(&bar[XB_TMO])) break; if (sp > XB_SPIN_CAP) { atomicAdd(&bar[XB_TMO], 1u); break; } }
    }
    nloc = mine > 0u ? mine : 1u; nx = cnt > 0u ? cnt : 1u;
}
__device__ __forceinline__ void xcd_barrier(const XcdBarrier& b) {
    asm volatile("s_waitcnt vmcnt(0)" ::: "memory");
    __syncthreads();
    if (threadIdx.x == 0) {
        unsigned* bar = b.bar;
        __builtin_amdgcn_s_waitcnt(0);
        unsigned nloc = b.st[0], nx = b.st[1];
        if (nloc == 0u) { xcd_barrier_complete(bar, b.x, nloc, nx); b.st[0] = nloc; b.st[1] = nx; }
        const unsigned old = xb_add(&bar[XB_XSUB(b.x)], 1u);
        const unsigned gen = old / nloc;
        if (old + 1u == (gen + 1u) * nloc) {
            __builtin_amdgcn_fence(__ATOMIC_RELEASE, "agent");
            asm volatile("s_waitcnt vmcnt(0)" ::: "memory");
            const unsigned og = xb_add(&bar[XB_TOP], 1u);
            const unsigned tg = og / nx;
            if (og + 1u == (tg + 1u) * nx) xb_add(&bar[XB_TOPGEN], 1u);
            else XB_SPIN(xb_ld(&bar[XB_TOPGEN]) == tg, bar);
            __builtin_amdgcn_fence(__ATOMIC_ACQUIRE, "agent");
            xb_add(&bar[XB_XGEN(b.x)], 1u);
            asm volatile("s_waitcnt vmcnt(0)" ::: "memory");
        } else {
            XB_SPIN(xb_ld(&bar[XB_XGEN(b.x)]) == gen, bar);
            __builtin_amdgcn_fence(__ATOMIC_ACQUIRE, "agent");
            asm volatile("s_waitcnt vmcnt(0)" ::: "memory");
        }
    }
    __syncthreads();
}

struct Args { const float* in[34]; float* out; unsigned char* ws; int ph_lo, ph_hi; };

struct Frame {
    LAS unsigned char* lds;
    int tid, lane, wave, vcu, G;
    const float* const* in;
    float* out; unsigned char* ws;
};
#define WSP(T_, off) ((T_*)(F.ws + (off)))

struct SchedInProj {
    const char* XN; const char* WQKU; const char* WV; int G, c;
    __device__ __forceinline__ bool next(int i, Unit& u) const { const int L = i * G + c; if (L >= 2144) return false; u.aux = 0;
        if (L < 1536) { u.pm = L / 6; u.pn = L % 6; u.grp = 0; } else if (L < 1600) { const int r = L - 1536; u.pm = 256 + (r >> 2); u.pn = 2 + (r & 3); u.grp = 0; }
        else { const int r = L - 1600; u.pm = r & 1; u.pn = r >> 1; u.grp = 1; } return true; }
    __device__ __forceinline__ unsigned arow(const Unit& u, int j) const { return (unsigned)(u.pm * 256 + j); }
    __device__ __forceinline__ const char* abase(const Unit& u) const { return u.grp ? WV : XN; }
    __device__ __forceinline__ const char* bbase(const Unit& u) const { return (u.grp ? XN : WQKU) + (size_t)u.pn * 256 * 1024; }
};
struct SchedGrid {
    const char* A; const char* B; int ldb, nN, n, G, c;
    __device__ __forceinline__ bool next(int i, Unit& u) const { const int L = i * G + c; if (L >= n) return false; u.pm = L / nN; u.pn = L % nN; u.grp = 0; u.aux = 0; return true; }
    __device__ __forceinline__ unsigned arow(const Unit& u, int j) const { return (unsigned)(u.pm * 256 + j); }
    __device__ __forceinline__ const char* abase(const Unit&) const { return A; }
    __device__ __forceinline__ const char* bbase(const Unit& u) const { return B + (size_t)u.pn * 256 * ldb * 2; }
};
struct SchedS5 {
    const char* A; const char* B; int ldb, rows_b, nM, nN, n, G, c; size_t abytes;
    __device__ __forceinline__ bool next(int i, Unit& u) const { const int L = i * G + c; if (L >= n) return false; const int per = nM * nN; u.grp = L / per; const int r = L % per; u.pm = r / nN; u.pn = r % nN; u.aux = 0; return true; }
    __device__ __forceinline__ unsigned arow(const Unit& u, int j) const { return (unsigned)(u.pm * 256 + j); }
    __device__ __forceinline__ const char* abase(const Unit& u) const { return A + (size_t)u.grp * abytes; }
    __device__ __forceinline__ const char* bbase(const Unit& u) const { return B + ((size_t)u.grp * rows_b + (size_t)u.pn * 256) * ldb * 2; }
};
struct SchedMoe {
    const char* A; const char* B; const LAS int* toff; const int* gcnt; const int* ltok; int glo, ghi, nN, ldb, rows_b, gather, G, c;
    __device__ __forceinline__ bool next(int i, Unit& u) const {
        const int L = i * G + c; const int t0 = toff[glo], t1 = toff[ghi]; if (L >= (t1 - t0) * nN) return false;
        const int mt = t0 + L / nN; u.pn = L % nN;
        const int lo = ((const LAS unsigned short*)(toff + 1024))[mt];
        u.grp = lo; u.pm = mt - toff[lo]; u.aux = mt; return true; }
    __device__ __forceinline__ unsigned arow(const Unit& u, int j) const {
        if (gather) { int idx = u.pm * 256 + j; const int cn = gcnt[u.grp]; idx = idx < cn ? idx : cn - 1; return (unsigned)ltok[u.grp * LISTCAP + idx]; }
        return (unsigned)(u.aux * 256 + j); }
    __device__ __forceinline__ const char* abase(const Unit&) const { return A; }
    __device__ __forceinline__ const char* bbase(const Unit& u) const { return B + ((size_t)(u.grp & 31) * rows_b + (size_t)u.pn * 256) * ldb * 2; }
    __device__ __forceinline__ void rows_dma(const Unit& u, LAS int* dst, int w, int lane) const {
        int idx = u.pm * 256 + w * 64 + lane; const int cn = toff[2304 + u.grp]; idx = idx < cn ? idx : cn - 1;
        __builtin_amdgcn_global_load_lds((const unsigned*)(ltok + (size_t)u.grp * LISTCAP + idx), (LAS unsigned*)(dst + w * 64), 4, 0, 0); }
};
template <> struct pg8::sched_gather<SchedMoe> { static constexpr bool v = true; };

struct SchedPair {
    const char* A; const char* B; const LAS int* toff2; int G, c;
    __device__ __forceinline__ bool next(int i, Unit& u) const {
        const int L = i * G + c; const int tot = toff2[NPAIR]; if (L >= tot * 4) return false;
        const int mt = L >> 2; u.pn = L & 3; const int lo = ((const LAS unsigned short*)(toff2 - 128 + 1536))[mt];
        u.grp = lo; u.pm = mt - toff2[lo]; u.aux = mt; return true; }
    __device__ __forceinline__ unsigned arow(const Unit& u, int j) const { return (unsigned)(u.aux * 256 + j); }
    __device__ __forceinline__ const char* abase(const Unit&) const { return A; }
    __device__ __forceinline__ void experts(const Unit& u, int& ea, int& eb) const { const int gi = u.grp / 28, p = u.grp % 28; int a = 0; while (a < 6 && (a + 1) * 8 - ((a + 1) * (a + 2)) / 2 <= p) ++a;
        const int b = a + 1 + (p - (a * 8 - (a * (a + 1)) / 2)); ea = gi * 8 + a; eb = gi * 8 + b; }
    __device__ __forceinline__ const char* bbase(const Unit& u) const { int ea, eb; experts(u, ea, eb); return B + ((size_t)ea * 1024 + (size_t)u.pn * 256) * 512; }
    __device__ __forceinline__ const char* bbase2(const Unit& u) const { int ea, eb; experts(u, ea, eb); return B + ((size_t)eb * 1024 + (size_t)u.pn * 256) * 512; }
};

typedef const f32x4 (&AccRef)[2][2][4][2];
struct EpiInProj {
    static constexpr bool PERM = true, AFTER_DRAIN = false; static constexpr int F8SC = 0x7a7a7a7a; static constexpr int NST = 16;
    unsigned char* Q; unsigned char* Kb; bf16_t* A2; unsigned char* A28; unsigned char* Vt; const LAS float* gq; const LAS float* gk; const LAS float* rope;
    __device__ __forceinline__ bool big(const Unit& u) const { return u.grp != 1 && (u.pn >> 1) == 2; }
    __device__ __forceinline__ void operator()(AccRef acc, const Unit& u, int wr, int wc, int fr, int fq) const {
        if (u.grp == 1) {
            const int tok0 = u.pn * 256; int b, pos0; if (tok0 < T) { b = tok0 >> 12; pos0 = tok0 & 4095; } else { b = (tok0 - T) >> 8; pos0 = SEQ; }
#pragma unroll
            for (int ai = 0; ai < 2; ++ai)
#pragma unroll
                for (int m = 0; m < 4; ++m) {
                    const int vcol = u.pm * 256 + ai * 128 + wr * 64 + m * 16 + fr;
                    unsigned char* rowp = Vt + ((size_t)b * 512 + vcol) * KV + pos0;
#pragma unroll
                    for (int bj = 0; bj < 2; ++bj) {
                        const f32x4 v0 = acc[ai][bj][m][0] * 8.f, v1 = acc[ai][bj][m][1] * 8.f;
                        int w0 = 0, w1 = 0; w0 = __builtin_amdgcn_cvt_pk_fp8_f32(v0[0], v0[1], w0, false); w0 = __builtin_amdgcn_cvt_pk_fp8_f32(v0[2], v0[3], w0, true);
                        w1 = __builtin_amdgcn_cvt_pk_fp8_f32(v1[0], v1[1], w1, false); w1 = __builtin_amdgcn_cvt_pk_fp8_f32(v1[2], v1[3], w1, true);
                        u32x2 w; w.x = (unsigned)w0; w.y = (unsigned)w1; *(u32x2*)(rowp + bj * 128 + wc * 32 + 8 * fq) = w; }
                }
            return;
        }
        const int ctx = u.pm >= 256; const int kind = u.pn >> 1;
        if (kind == 2) {
#pragma unroll
            for (int ai = 0; ai < 2; ++ai)
#pragma unroll
                for (int m = 0; m < 4; ++m) {
                    const int row = u.pm * 256 + ai * 128 + wr * 64 + m * 16 + fr;
                    int b, pos; if (!ctx) { b = row >> 12; pos = row & 4095; } else { b = (row - T) >> 8; pos = (row - T) & 255; }
                    const int r2 = ctx ? (A2_LAT + b * 8 + (pos >> 5)) : (b * 128 + (pos >> 5));
#pragma unroll
                    for (int bj = 0; bj < 2; ++bj) {
                        const int col = (u.pn & 1) * 256 + bj * 128 + wc * 32 + 8 * fq; const int g = col >> 4, ch = col & 15;
                        const f32x4 v0 = acc[ai][bj][m][0], v1 = acc[ai][bj][m][1];
                        u32x4 w; w.x = cvt_pk_bf16(v0[0], v0[1]); w.y = cvt_pk_bf16(v0[2], v0[3]); w.z = cvt_pk_bf16(v1[0], v1[1]); w.w = cvt_pk_bf16(v1[2], v1[3]);
                        *(u32x4*)(A2 + ((size_t)g * A2_ROWS + r2) * A2_LD + (pos & 31) * 16 + ch) = w;
                        *(u32x2*)(A28 + ((size_t)g * A2_ROWS + r2) * 768 + (pos & 31) * 16 + ch) = pack8_fp8(v0[0], v0[1], v0[2], v0[3], v1[0], v1[1], v1[2], v1[3]); }
                }
            return;
        }
        const int chunk = (u.pn & 1) * 4 + wc, dbase = (fq >> 1) * 32 + (fq & 1) * 8, axis = fq >> 1, i0 = (fq & 1) * 8;
        const LAS float* gs = kind == 0 ? gq : gk;
        const f32x4 ga0 = *(const LAS f32x4*)(gs + dbase), ga1 = *(const LAS f32x4*)(gs + dbase + 4), gb0 = *(const LAS f32x4*)(gs + dbase + 16), gb1 = *(const LAS f32x4*)(gs + dbase + 20);
        const float qs = kind == 0 ? C2 * 16.f : 1.f;
#pragma unroll
        for (int ai = 0; ai < 2; ++ai)
#pragma unroll
            for (int m = 0; m < 4; ++m) {
                const int row = u.pm * 256 + ai * 128 + wr * 64 + m * 16 + fr;
                int b, pos; if (!ctx) { b = row >> 12; pos = row & 4095; } else { b = (row - T) >> 8; pos = (row - T) & 255; }
                const f32x4 a0 = acc[ai][0][m][0], a1 = acc[ai][0][m][1], b0 = acc[ai][1][m][0], b1 = acc[ai][1][m][1];
                float ss = (a0[0] * a0[0] + a0[1] * a0[1] + a0[2] * a0[2] + a0[3] * a0[3]) + (a1[0] * a1[0] + a1[1] * a1[1] + a1[2] * a1[2] + a1[3] * a1[3])
                         + (b0[0] * b0[0] + b0[1] * b0[1] + b0[2] * b0[2] + b0[3] * b0[3]) + (b1[0] * b1[0] + b1[1] * b1[1] + b1[2] * b1[2] + b1[3] * b1[3]);
                ss += __shfl_xor(ss, 16); ss += __shfl_xor(ss, 32);
                const float rn = qs / sqrtf(ss * (1.f / 64.f) + RMS_EPS);
                f32x4 y0 = a0 * rn * ga0, y1 = a1 * rn * ga1, z0 = b0 * rn * gb0, z1 = b1 * rn * gb1;
                if (!ctx) {
                    const int p = axis ? (pos & 63) : (pos >> 6); const LAS float* cp = rope + p * 16 + i0;
                    const f32x4 c0 = *(const LAS f32x4*)cp, c1 = *(const LAS f32x4*)(cp + 4), s0 = *(const LAS f32x4*)(cp + 1024), s1 = *(const LAS f32x4*)(cp + 1028);
                    const f32x4 o0 = y0 * c0 - z0 * s0, o1 = y1 * c1 - z1 * s1, p0 = z0 * c0 + y0 * s0, p1 = z1 * c1 + y1 * s1;
                    y0 = o0; y1 = o1; z0 = p0; z1 = p1;
                }
                int a0_ = 0, a1_ = 0, b0_ = 0, b1_ = 0;
                a0_ = __builtin_amdgcn_cvt_pk_fp8_f32(y0[0], y0[1], a0_, false); a0_ = __builtin_amdgcn_cvt_pk_fp8_f32(y0[2], y0[3], a0_, true); a1_ = __builtin_amdgcn_cvt_pk_fp8_f32(y1[0], y1[1], a1_, false); a1_ = __builtin_amdgcn_cvt_pk_fp8_f32(y1[2], y1[3], a1_, true);
                b0_ = __builtin_amdgcn_cvt_pk_fp8_f32(z0[0], z0[1], b0_, false); b0_ = __builtin_amdgcn_cvt_pk_fp8_f32(z0[2], z0[3], b0_, true); b1_ = __builtin_amdgcn_cvt_pk_fp8_f32(z1[0], z1[1], b1_, false); b1_ = __builtin_amdgcn_cvt_pk_fp8_f32(z1[2], z1[3], b1_, true);
                u32x2 w0, w1; w0.x = (unsigned)a0_; w0.y = (unsigned)a1_; w1.x = (unsigned)b0_; w1.y = (unsigned)b1_;
                unsigned char* dst = (kind == 0 ? Q + (size_t)row * 512 : Kb + ((size_t)b * KV + (ctx ? SEQ + pos : pos)) * 512) + chunk * 64 + dbase;
                *(u32x2*)dst = w0; *(u32x2*)(dst + 16) = w1;
            }
    }
};
template <> struct pg8::epi_nst2<EpiInProj> { static constexpr bool v = true; static constexpr int n = 32; };
struct EpiS5State {
    static constexpr bool PERM = false, AFTER_DRAIN = false; static constexpr int F8SC = 0x7f7f7f7f; static constexpr int NST = 32;
    unsigned* Sb;
    __device__ __forceinline__ void operator()(AccRef acc, const Unit& u, int wr, int wc, int fr, int fq) const {
#pragma unroll
        for (int ai = 0; ai < 2; ++ai)
#pragma unroll
            for (int m = 0; m < 4; ++m) {
                const int row = u.pm * 256 + ai * 128 + wr * 64 + m * 16 + fr;
                unsigned* rowp = Sb + ((size_t)u.grp * A2_ROWS + row) * 128 + wc * 16 + 2 * fq;
#pragma unroll
                for (int bj = 0; bj < 2; ++bj)
#pragma unroll
                    for (int n = 0; n < 2; ++n) { const f32x4 a = acc[ai][bj][m][n]; u32x2 o; o.x = cvt_pk_bf16(a[0], a[1]); o.y = cvt_pk_bf16(a[2], a[3]); *(u32x2*)(rowp + bj * 64 + n * 8) = o; }
            }
    }
};
__device__ __forceinline__ float gelu_tanh(float x) {
    const float z = 1.5957691216057308f * (x + 0.044715f * x * x * x);
    return x * sigmoidf_(z);
}
struct EpiS5Out {
    static constexpr bool PERM = true, AFTER_DRAIN = false; static constexpr int F8SC = 0x79797979;        static constexpr int NST = 16;
    unsigned char* Yg;
    __device__ __forceinline__ void operator()(AccRef acc, const Unit& u, int wr, int wc, int fr, int fq) const {
#pragma unroll
        for (int ai = 0; ai < 2; ++ai)
#pragma unroll
            for (int m = 0; m < 4; ++m) {
                const int row = u.pm * 256 + ai * 128 + wr * 64 + m * 16 + fr; const int b = row >> 7, ck = row & 127;
#pragma unroll
                for (int bj = 0; bj < 2; ++bj) {
                    const int col = u.pn * 256 + bj * 128 + wc * 32 + 8 * fq; const int tl = col >> 4, ch = col & 15;
                    const f32x4 v0 = acc[ai][bj][m][0], v1 = acc[ai][bj][m][1];
                    *(u32x2*)(Yg + ((size_t)b * SEQ + ck * 32 + tl) * 512 + u.grp * 16 + ch) = pack8_fp8(gelu_tanh(v0[0]), gelu_tanh(v0[1]), gelu_tanh(v0[2]), gelu_tanh(v0[3]), gelu_tanh(v1[0]), gelu_tanh(v1[1]), gelu_tanh(v1[2]), gelu_tanh(v1[3])); }
            }
    }
};
struct EpiGlu {
    static constexpr bool PERM = true, AFTER_DRAIN = false; static constexpr int F8SC = 0x7a7a7a7a; static constexpr int NST = 16;
    const unsigned char* Yg; const float* bglu; bf16_t* AO;
    __device__ __forceinline__ void operator()(AccRef acc, const Unit& u, int wr, int wc, int fr, int fq) const {
#pragma unroll
        for (int ai = 0; ai < 2; ++ai)
#pragma unroll
            for (int m = 0; m < 4; ++m) {
                const int row = u.pm * 256 + ai * 128 + wr * 64 + m * 16 + fr;
#pragma unroll
                for (int bj = 0; bj < 2; ++bj) {
                    const int col = u.pn * 256 + bj * 128 + wc * 32 + 8 * fq;
                    const u32x2 y8 = *(const u32x2*)(Yg + (size_t)row * 512 + col);
                    const f32x2 ya = __builtin_amdgcn_cvt_pk_f32_fp8((int)y8.x, false), yb = __builtin_amdgcn_cvt_pk_f32_fp8((int)y8.x, true), yc = __builtin_amdgcn_cvt_pk_f32_fp8((int)y8.y, false), yd = __builtin_amdgcn_cvt_pk_f32_fp8((int)y8.y, true);
                    const f32x4 b0 = *(const f32x4*)(bglu + col), b1 = *(const f32x4*)(bglu + col + 4);
                    const f32x4 v0 = acc[ai][bj][m][0] + b0, v1 = acc[ai][bj][m][1] + b1;
                    u32x4 w;
                    w.x = cvt_pk_bf16(ya[0] * sigmoidf_(v0[0]), ya[1] * sigmoidf_(v0[1])); w.y = cvt_pk_bf16(yb[0] * sigmoidf_(v0[2]), yb[1] * sigmoidf_(v0[3]));
                    w.z = cvt_pk_bf16(yc[0] * sigmoidf_(v1[0]), yc[1] * sigmoidf_(v1[1])); w.w = cvt_pk_bf16(yd[0] * sigmoidf_(v1[2]), yd[1] * sigmoidf_(v1[3]));
                    *(u32x4*)(AO + (size_t)row * 1024 + 512 + col) = w; }
            }
    }
};
struct EpiOut {
    static constexpr bool PERM = true, AFTER_DRAIN = false; static constexpr int F8SC = 0x7f7f7f7f; static constexpr int NST = 16;
    const float* x; const float* mod; bf16_t* x1b;
    __device__ __forceinline__ void operator()(AccRef acc, const Unit& u, int wr, int wc, int fr, int fq) const {
        const int b = (u.pm * 256) >> 12; const float* g1 = mod + (size_t)b * 6144 + 2048;
#pragma unroll
        for (int ai = 0; ai < 2; ++ai)
#pragma unroll
            for (int m = 0; m < 4; ++m) {
                const size_t row = (size_t)u.pm * 256 + ai * 128 + wr * 64 + m * 16 + fr;
#pragma unroll
                for (int bj = 0; bj < 2; ++bj) { const int col = u.pn * 256 + bj * 128 + wc * 32 + 8 * fq;
                    const f32x4 x0 = *(const f32x4*)(x + row * 1024 + col), x1 = *(const f32x4*)(x + row * 1024 + col + 4), g0 = *(const f32x4*)(g1 + col), g1v = *(const f32x4*)(g1 + col + 4);
                    const f32x4 v0 = x0 + g0 * acc[ai][bj][m][0], v1 = x1 + g1v * acc[ai][bj][m][1];
                    u32x4 w; w.x = cvt_pk_bf16(v0[0], v0[1]); w.y = cvt_pk_bf16(v0[2], v0[3]); w.z = cvt_pk_bf16(v1[0], v1[1]); w.w = cvt_pk_bf16(v1[2], v1[3]);
                    *(u32x4*)(x1b + row * 1024 + col) = w; }
            }
    }
};
struct EpiGateUp {
    static constexpr bool PERM = true, AFTER_DRAIN = false; static constexpr int F8SC = 0x7f7f7f7f; static constexpr int NST = 8;
    unsigned char* H2; const int* gcnt; const float* lw; const int* lrow; const LAS int* toff2; unsigned char* trash;
    __device__ __forceinline__ void rows_dma(const Unit& u, LAS int* dst, int w, int lane) const {
        int idx = u.pm * 256 + (w & 3) * 64 + lane; const int cn = toff2[2176 + u.grp]; idx = idx < cn ? idx : cn - 1; const size_t li = (size_t)u.grp * LISTCAP + idx;
        if (w < 4) __builtin_amdgcn_global_load_lds((const unsigned*)(lrow + li), (LAS unsigned*)(dst + w * 64), 4, 0, 0);
        else __builtin_amdgcn_global_load_lds((const unsigned*)(lw + li), (LAS unsigned*)(dst + 256 + (w & 3) * 64), 4, 0, 0); }
    __device__ __forceinline__ void operator()(AccRef acc, const Unit& u, int wr, int wc, int fr, int fq, const LAS int* tl) const {
        const int cn = toff2[2176 + u.grp];
#pragma unroll
        for (int ai = 0; ai < 2; ++ai)
#pragma unroll
            for (int m = 0; m < 4; ++m) {
                const int rl = ai * 128 + wr * 64 + m * 16 + fr, idx = u.pm * 256 + rl; const bool valid = idx < cn;
                const int lr = tl[rl]; const float wgt = valid ? __builtin_bit_cast(float, tl[256 + rl]) * (1.f / 32.f) : 0.f;
                const size_t row2 = (size_t)toff2[lr >> 17] * 256 + ((lr >> 1) & 0xffff);
                unsigned char* dst = valid ? H2 + row2 * 1024 + (lr & 1) * 512 + u.pn * 128 + wc * 32 + 8 * fq : trash + 8 * fq;
                const f32x4 g0 = acc[ai][0][m][0] * (1.f / 32.f), g1 = acc[ai][0][m][1] * (1.f / 32.f), u0 = acc[ai][1][m][0] * wgt, u1 = acc[ai][1][m][1] * wgt;
                int w0 = 0, w1 = 0;
                w0 = __builtin_amdgcn_cvt_pk_fp8_f32(g0[0] * sigmoidf_(g0[0]) * u0[0], g0[1] * sigmoidf_(g0[1]) * u0[1], w0, false); w0 = __builtin_amdgcn_cvt_pk_fp8_f32(g0[2] * sigmoidf_(g0[2]) * u0[2], g0[3] * sigmoidf_(g0[3]) * u0[3], w0, true);
                w1 = __builtin_amdgcn_cvt_pk_fp8_f32(g1[0] * sigmoidf_(g1[0]) * u1[0], g1[1] * sigmoidf_(g1[1]) * u1[1], w1, false); w1 = __builtin_amdgcn_cvt_pk_fp8_f32(g1[2] * sigmoidf_(g1[2]) * u1[2], g1[3] * sigmoidf_(g1[3]) * u1[3], w1, true);
                u32x2 o8; o8.x = (unsigned)w0; o8.y = (unsigned)w1;
                *(u32x2*)dst = o8;
            }
    }
};
template <> struct pg8::epi_rows<EpiGateUp> { static constexpr bool v = true; static constexpr int nw = 8, off = 12288, stride = 2048; };
struct EpiDown2 {
    static constexpr bool PERM = true, AFTER_DRAIN = false; static constexpr int F8SC = 0x7f7f7f7f; static constexpr int NST = 32;
    const int* gcnt2; const int* ptok; const float* mod; const bf16_t* x1b; float* out; unsigned char* trash; const LAS int* cnl;
    __device__ __forceinline__ void rows_dma(const Unit& u, LAS int* dst, int w, int lane) const {
        int idx = u.pm * 256 + w * 64 + lane; const int cn = cnl[u.grp]; idx = idx < cn ? idx : cn - 1;
        __builtin_amdgcn_global_load_lds((const unsigned*)(ptok + (size_t)u.grp * LISTCAP + idx), (LAS unsigned*)(dst + w * 64), 4, 0, 0); }
    __device__ __forceinline__ void operator()(AccRef acc, const Unit& u, int wr, int wc, int fr, int fq, const LAS int* tl) const {
        const int cn = cnl[u.grp];
#pragma unroll
        for (int ai = 0; ai < 2; ++ai)
#pragma unroll
            for (int m = 0; m < 4; ++m) {
                const int rl = ai * 128 + wr * 64 + m * 16 + fr, idx = u.pm * 256 + rl; const bool valid = idx < cn;
                const int tok = tl[rl];
                const float* g2 = mod + (size_t)(tok >> 12) * 6144 + 5120; float* orow = valid ? out + (size_t)tok * 1024 : (float*)trash;
#pragma unroll
                for (int bj = 0; bj < 2; ++bj) { const int col = u.pn * 256 + bj * 128 + wc * 32 + 8 * fq; const int ocol = valid ? col : 8 * fq;
                    const f32x4 g0 = *(const f32x4*)(g2 + col) * (1.f / 16.f), g1 = *(const f32x4*)(g2 + col + 4) * (1.f / 16.f);
                    const u32x4 xa = *(const u32x4*)(x1b + (size_t)tok * 1024 + col);
                    const f32x4 v0 = g0 * acc[ai][bj][m][0], v1 = g1 * acc[ai][bj][m][1];
                    f32x4 o0, o1;
                    o0[0] = bf_lo(xa.x) + v0[0]; o0[1] = bf_hi(xa.x) + v0[1]; o0[2] = bf_lo(xa.y) + v0[2]; o0[3] = bf_hi(xa.y) + v0[3];
                    o1[0] = bf_lo(xa.z) + v1[0]; o1[1] = bf_hi(xa.z) + v1[1]; o1[2] = bf_lo(xa.w) + v1[2]; o1[3] = bf_hi(xa.w) + v1[3];
                    *(f32x4*)(orow + ocol) = o0; *(f32x4*)(orow + ocol + 4) = o1; }
            }
    }
};
template <> struct pg8::epi_rows<EpiDown2> { static constexpr bool v = true; static constexpr int nw = 4, off = 10240, stride = 1024; };

struct TrItem { const float* W; bf16_t* d; int K, N, k0, n0, rowoff, qkperm, fp8; float sc; };
__device__ __forceinline__ int qk_row(int n) { const int blk = n & ~511, nl = n & 511, chunk = nl >> 6, d = nl & 63; const int a = d >> 5, bj = (d >> 4) & 1, f1 = (d >> 3) & 1, e = d & 7;
    return blk + (chunk >> 2) * 256 + 128 * bj + 32 * (chunk & 3) + 8 * (a * 2 + f1) + e; }
__device__ __forceinline__ TrItem tr_decode(const float* const* in, unsigned char* ws, int it) {
    TrItem t;
    const float* W; bf16_t* d; int K, N, mode, sub;
    if (it < 1024) { W = in[7]; K = 1024; N = 2048; d = (bf16_t*)(ws + WS_WQKU); mode = 1; sub = it; }
    else if (it < 1024 + 128) { W = in[23]; K = 512; N = 512; d = (bf16_t*)(ws + WS_WGLU); mode = 5; sub = it - 1024; }
    else if (it < 1024 + 128 + 512) { W = in[25]; K = 1024; N = 1024; d = (bf16_t*)(ws + WS_WOUT); mode = 0; sub = it - 1152; }
    else { const int r = it - 1664, e = r / 768, q = r % 768, which = q >> 8; sub = q & 255;
        if (which == 0) { W = in[31] + (size_t)e * 1024 * 512; K = 1024; N = 512; d = (bf16_t*)(ws + WS_WGU + (size_t)e * 1024 * 1024); mode = 2; }
        else if (which == 1) { W = in[32] + (size_t)e * 1024 * 512; K = 1024; N = 512; d = (bf16_t*)(ws + WS_WGU + (size_t)e * 1024 * 1024); mode = 3; }
        else { W = in[33] + (size_t)e * 512 * 1024; K = 512; N = 1024; d = (bf16_t*)(ws + WS_WD + (size_t)e * 1024 * 512); mode = 4; } }
    const int nblk = N / 32, kb = sub / nblk, nb = sub % nblk; t.W = W; t.K = K; t.N = N; t.k0 = kb * 64; t.n0 = nb * 32;
    const int n0 = t.n0; int ro = 0;
    if (mode == 1) { if (n0 >= 1024 && n0 < 1536) { d = (bf16_t*)(ws + WS_WV); ro = -1024; } else if (n0 >= 1536) ro = -512; }
    else if (mode == 2) ro = (n0 >> 7) * 128;
    else if (mode == 3) ro = (n0 >> 7) * 128 + 128;
    t.d = d; t.rowoff = ro; t.qkperm = (mode == 1 && n0 < 1024) ? 1 : 0; t.fp8 = (mode >= 1 && mode <= 5) ? 1 : 0; t.sc = mode == 4 ? 16.f : 32.f; return t;
}
__device__ __forceinline__ void tr_load(const TrItem& t, int lane, f32x4 (&v)[8]) {
#pragma unroll
    for (int i = 0; i < 8; ++i) v[i] = *(const f32x4*)(t.W + (size_t)(t.k0 + (lane >> 3) + 8 * i) * t.N + t.n0 + (lane & 7) * 4);
}
__device__ __forceinline__ void tr_store(const TrItem& t, int lane, const f32x4 (&v)[8], LAS float* scr) {
#pragma unroll
    for (int i = 0; i < 8; ++i) { LAS float* p = scr + ((lane >> 3) + 8 * i) * 33 + (lane & 7) * 4; p[0] = v[i][0]; p[1] = v[i][1]; p[2] = v[i][2]; p[3] = v[i][3]; }
    asm volatile("s_waitcnt lgkmcnt(0)" ::: "memory");
#pragma unroll
    for (int j = 0; j < 4; ++j) { const int n = (lane >> 3) + 8 * j, kc = (lane & 7) * 8; const LAS float* q = scr + kc * 33 + n;
        u32x4 o; o.x = cvt_pk_bf16(q[0], q[33]); o.y = cvt_pk_bf16(q[2 * 33], q[3 * 33]); o.z = cvt_pk_bf16(q[4 * 33], q[5 * 33]); o.w = cvt_pk_bf16(q[6 * 33], q[7 * 33]);
        const int row = t.qkperm ? qk_row(t.n0 + n) : t.n0 + n + t.rowoff;
        if (t.fp8) { int w0 = 0, w1 = 0; const float SC = t.sc;
            w0 = __builtin_amdgcn_cvt_pk_fp8_f32(q[0] * SC, q[33] * SC, w0, false); w0 = __builtin_amdgcn_cvt_pk_fp8_f32(q[2 * 33] * SC, q[3 * 33] * SC, w0, true);
            w1 = __builtin_amdgcn_cvt_pk_fp8_f32(q[4 * 33] * SC, q[5 * 33] * SC, w1, false); w1 = __builtin_amdgcn_cvt_pk_fp8_f32(q[6 * 33] * SC, q[7 * 33] * SC, w1, true);
            u32x2 o8; o8.x = (unsigned)w0; o8.y = (unsigned)w1; *(u32x2*)((unsigned char*)t.d + (size_t)row * t.K + t.k0 + kc) = o8; }
        else *(u32x4*)(t.d + (size_t)row * t.K + t.k0 + kc) = o; }
    asm volatile("s_waitcnt lgkmcnt(0)" ::: "memory");
}
__device__ __forceinline__ void tr8_load(const TrItem& t, int lane, float (&v)[32]) {
    const float* p = t.W + (size_t)(t.k0 + 32 * (lane >> 5)) * t.N + t.n0 + (lane & 31);
#pragma unroll
    for (int i = 0; i < 32; ++i) v[i] = p[(size_t)i * t.N];
}
__device__ __forceinline__ void tr8_store(const TrItem& t, int lane, const float (&v)[32]) {
    const int nl = lane & 31; const int row = t.qkperm ? qk_row(t.n0 + nl) : t.n0 + nl + t.rowoff; const float SC = t.sc;
    int w[8];
#pragma unroll
    for (int j = 0; j < 8; ++j) { int x = 0; x = __builtin_amdgcn_cvt_pk_fp8_f32(v[4 * j] * SC, v[4 * j + 1] * SC, x, false); x = __builtin_amdgcn_cvt_pk_fp8_f32(v[4 * j + 2] * SC, v[4 * j + 3] * SC, x, true); w[j] = x; }
    unsigned char* dst = (unsigned char*)t.d + (size_t)row * t.K + t.k0 + 32 * (lane >> 5);
    u32x4 a, b; a.x = (unsigned)w[0]; a.y = (unsigned)w[1]; a.z = (unsigned)w[2]; a.w = (unsigned)w[3]; b.x = (unsigned)w[4]; b.y = (unsigned)w[5]; b.z = (unsigned)w[6]; b.w = (unsigned)w[7];
    *(u32x4*)dst = a; *(u32x4*)(dst + 16) = b;
}
constexpr int NTR_NONEXP = 1664, NTR_ITEMS = 1664 + 32 * 768;
__device__ __forceinline__ void adaln_item(const float* c, const float* cctx, const float* wada, const float* bada, float* mod, int item, LAS float* L, int tid) {
    LAS float* st = L;
    LAS float* red = L + 17 * 1024;
    { float cv[34];
#pragma unroll
      for (int j = 0; j < 34; ++j) { const int idx = tid + j * 512; cv[j] = j < 32 ? c[idx] : cctx[idx - 16384]; }
#pragma unroll
      for (int j = 0; j < 34; ++j) { const float v = cv[j]; st[tid + j * 512] = v / (1.f + __expf(-v)); } }
    __syncthreads();
    const int n0 = item * 32, col = tid & 31, ks = tid >> 5;
    float acc[17];
#pragma unroll
    for (int r = 0; r < 17; ++r) acc[r] = 0.f;
    for (int kb = 0; kb < 64; kb += 16) { float w[16];
#pragma unroll
        for (int q = 0; q < 16; ++q) w[q] = wada[(size_t)(ks * 64 + kb + q) * 6144 + n0 + col];
#pragma unroll
        for (int q = 0; q < 16; ++q) { const int k = ks * 64 + kb + q;
#pragma unroll
            for (int r = 0; r < 17; ++r) acc[r] += st[r * 1024 + k] * w[q]; } }
#pragma unroll
    for (int r = 0; r < 17; ++r) red[(ks * 17 + r) * 32 + col] = acc[r];
    __syncthreads();
    for (int idx = tid; idx < 17 * 32; idx += 512) { const int r = idx >> 5, cc = idx & 31; float s = 0.f;
#pragma unroll
        for (int k = 0; k < 16; ++k) s += red[(k * 17 + r) * 32 + cc];
        mod[(size_t)r * 6144 + n0 + cc] = s + bada[n0 + cc]; }
    __syncthreads();
}
__device__ __forceinline__ void s5_disc(const float* are, const float* aim, const float* ldt, int dir, int g, int p, float& lr, float& li, float& cr, float& ci) {
    const float dt = expf(ldt[dir * 32 + g]); const float ar = are[(dir * 32 + g) * 64 + p], ai = aim[(dir * 32 + g) * 64 + p];
    const float mag = expf(ar * dt); float sn, cs; sincosf(ai * dt, &sn, &cs);
    lr = mag * cs; li = mag * sn;
    const float den = ar * ar + ai * ai, nr = lr - 1.f, ni = li;
    cr = (nr * ar + ni * ai) / den; ci = (ni * ar - nr * ai) / den;
}
__device__ __forceinline__ void s5_item_lag(const float* const* in, unsigned char* W2, int item, LAS float* L, int tid) {
    const int g = item >> 2, j0 = (item & 3) * 8;
    LAS float* lamj = L;
    LAS float* lam1 = L + 256;
    LAS float* Bb = L + 512;
    LAS float* Gm = L + 512 + 4096;
    LAS float* Cm = L + 512 + 8192;
    LAS float* Kt = L + 512 + 8192 + 2048;
    LAS float* coef = Kt + 512;
    if (tid < 128) { const int dir = tid >> 6, p = tid & 63; float lr, li, cr, ci; s5_disc(in[15], in[16], in[17], dir, g, p, lr, li, cr, ci);
        float pr = 1.f, pi = 0.f; for (int e = 0; e < j0; ++e) { const float t = pr * lr - pi * li; pi = pr * li + pi * lr; pr = t; }
        lamj[tid * 2] = pr; lamj[tid * 2 + 1] = pi; lam1[tid * 2] = lr; lam1[tid * 2 + 1] = li; coef[tid * 2] = cr; coef[tid * 2 + 1] = ci; }
    for (int idx = tid; idx < 1024; idx += 512) { const int ho = idx >> 6, p = idx & 63; Cm[idx * 2] = in[20][(g * 16 + ho) * 64 + p]; Cm[idx * 2 + 1] = in[21][(g * 16 + ho) * 64 + p]; }
    __syncthreads();
    for (int idx = tid; idx < 2048; idx += 512) { const int dir = idx >> 10, p = (idx >> 4) & 63, hi = idx & 15;
        const float br = in[18][((size_t)(dir * 32 + g) * 64 + p) * 16 + hi], bi = in[19][((size_t)(dir * 32 + g) * 64 + p) * 16 + hi];
        const float cr = coef[(dir * 64 + p) * 2], ci = coef[(dir * 64 + p) * 2 + 1];
        Bb[idx * 2] = cr * br - ci * bi; Bb[idx * 2 + 1] = cr * bi + ci * br; }
    unsigned char* Wg = W2 + (size_t)g * 512 * 768;
    for (int j = j0; j < j0 + 8; ++j) {
        __syncthreads();
        for (int idx = tid; idx < 2048; idx += 512) { const int dp = idx >> 4; const float pr = lamj[dp * 2], pi = lamj[dp * 2 + 1], bbr = Bb[idx * 2], bbi = Bb[idx * 2 + 1];
            Gm[idx * 2] = pr * bbr - pi * bbi; Gm[idx * 2 + 1] = pr * bbi + pi * bbr; }
        __syncthreads();
        { const int dir = tid >> 8, ho = (tid >> 4) & 15, hi = tid & 15; float sacc = 0.f;
            for (int p = 0; p < 64; ++p) sacc += Cm[(ho * 64 + p) * 2] * Gm[((dir * 64 + p) * 16 + hi) * 2] - Cm[(ho * 64 + p) * 2 + 1] * Gm[((dir * 64 + p) * 16 + hi) * 2 + 1];
            Kt[tid] = sacc; }
        if (tid < 128) { const float pr = lamj[tid * 2], pi = lamj[tid * 2 + 1], lr = lam1[tid * 2], li = lam1[tid * 2 + 1]; lamj[tid * 2] = pr * lr - pi * li; lamj[tid * 2 + 1] = pr * li + pi * lr; }
        __syncthreads();
        if (j == 0) {
            for (int idx = tid; idx < 32 * 32; idx += 512) { const int t = idx >> 5, ho = (idx >> 1) & 15, hb = (idx & 1) * 8; float v[8];
#pragma unroll
                for (int e = 0; e < 8; ++e) { v[e] = Kt[ho * 16 + hb + e] + Kt[256 + ho * 16 + hb + e] + ((hb + e) == ho ? in[22][g * 16 + ho] : 0.f); }
                *(u32x2*)(Wg + (size_t)(t * 16 + ho) * 768 + t * 16 + hb) = pack8_fp8(v[0] * 64.f, v[1] * 64.f, v[2] * 64.f, v[3] * 64.f, v[4] * 64.f, v[5] * 64.f, v[6] * 64.f, v[7] * 64.f); }
        } else {
            const int nb = 32 - j;
            for (int idx = tid; idx < 2 * nb * 32; idx += 512) { const int dir = idx / (nb * 32), r = idx % (nb * 32), q = r >> 5, ho = (r >> 1) & 15, hb = (r & 1) * 8;
                const int t = dir == 0 ? q + j : q, sx = dir == 0 ? q : q + j; const LAS float* kp = Kt + dir * 256 + ho * 16 + hb;
                *(u32x2*)(Wg + (size_t)(t * 16 + ho) * 768 + sx * 16 + hb) = pack8_fp8(kp[0] * 64.f, kp[1] * 64.f, kp[2] * 64.f, kp[3] * 64.f, kp[4] * 64.f, kp[5] * 64.f, kp[6] * 64.f, kp[7] * 64.f); }
        }
    }
    __syncthreads();
}
__device__ __forceinline__ void s5_item_state(const float* const* in, bf16_t* W1, unsigned char* W2, int item, LAS float* L, int tid) {
    const int g = item >> 1, dir = item & 1;
    LAS float* pw = L;
    LAS float* Bb = L + 33 * 128;
    LAS float* Cm = Bb + 2048;
    LAS float* coef = Cm + 2048;
    if (tid < 64) { const int p = tid; float lr, li, cr, ci; s5_disc(in[15], in[16], in[17], dir, g, p, lr, li, cr, ci);
        float pr = 1.f, pi = 0.f; for (int e = 0; e <= 32; ++e) { pw[(e * 64 + p) * 2] = pr; pw[(e * 64 + p) * 2 + 1] = pi; const float t = pr * lr - pi * li; pi = pr * li + pi * lr; pr = t; }
        coef[p * 2] = cr; coef[p * 2 + 1] = ci; }
    for (int idx = tid; idx < 1024; idx += 512) { const int ho = idx >> 6, p = idx & 63; Cm[idx * 2] = in[20][(g * 16 + ho) * 64 + p]; Cm[idx * 2 + 1] = in[21][(g * 16 + ho) * 64 + p]; }
    __syncthreads();
    for (int idx = tid; idx < 1024; idx += 512) { const int p = idx >> 4, hi = idx & 15;
        const float br = in[18][((size_t)(dir * 32 + g) * 64 + p) * 16 + hi], bi = in[19][((size_t)(dir * 32 + g) * 64 + p) * 16 + hi];
        const float cr = coef[p * 2], ci = coef[p * 2 + 1]; Bb[idx * 2] = cr * br - ci * bi; Bb[idx * 2 + 1] = cr * bi + ci * br; }
    __syncthreads();
    bf16_t* W1g = W1 + ((size_t)g * 256 + dir * 128) * 512;
    for (int idx = tid; idx < 128 * 64; idx += 512) { const int n = idx >> 6, kc = idx & 63, part = n >> 6, p = n & 63, s = kc >> 1, hb = (kc & 1) * 8;
        const int e = dir == 0 ? 31 - s : s; const float pr = pw[(e * 64 + p) * 2], pi = pw[(e * 64 + p) * 2 + 1]; float v[8];
#pragma unroll
        for (int q = 0; q < 8; ++q) { const float br = Bb[(p * 16 + hb + q) * 2], bi = Bb[(p * 16 + hb + q) * 2 + 1]; v[q] = part == 0 ? pr * br - pi * bi : pr * bi + pi * br; }
        u32x4 o; o.x = cvt_pk_bf16(v[0], v[1]); o.y = cvt_pk_bf16(v[2], v[3]); o.z = cvt_pk_bf16(v[4], v[5]); o.w = cvt_pk_bf16(v[6], v[7]);
        *(u32x4*)(W1g + (size_t)(2 * p + part) * 512 + s * 16 + hb) = o; }
    unsigned char* W2g = W2 + (size_t)g * 512 * 768 + 512 + dir * 128;
    for (int idx = tid; idx < 512 * 16; idx += 512) { const int n = idx >> 4, cc = idx & 15, t = n >> 4, ho = n & 15, part = cc >> 3, p0 = (cc & 7) * 8;
        const int e = dir == 0 ? t + 1 : 32 - t; float v[8];
#pragma unroll
        for (int q = 0; q < 8; ++q) { const int p = p0 + q; const float pr = pw[(e * 64 + p) * 2], pi = pw[(e * 64 + p) * 2 + 1], c_r = Cm[(ho * 64 + p) * 2], c_i = Cm[(ho * 64 + p) * 2 + 1];
            v[q] = part == 0 ? (c_r * pr - c_i * pi) : -(c_r * pi + c_i * pr); }
        *(u32x2*)(W2g + (size_t)n * 768 + part * 64 + p0) = pack8_fp8(v[0] * 64.f, v[1] * 64.f, v[2] * 64.f, v[3] * 64.f, v[4] * 64.f, v[5] * 64.f, v[6] * 64.f, v[7] * 64.f); }
    __syncthreads();
}
__device__ __forceinline__ void wr_item(const float* wrg, const float* wre, bf16_t* Wr, int item, int tid) {
    const int r = item * 4 + (tid >> 7), k0 = (tid & 127) * 8; float v[8];
#pragma unroll
    for (int q = 0; q < 8; ++q) { const int k = k0 + q; v[q] = r < 4 ? wrg[k * 4 + r] : (r < 36 ? wre[k * 32 + (r - 4)] : 0.f); }
    u32x4 o; o.x = cvt_pk_bf16(v[0], v[1]); o.y = cvt_pk_bf16(v[2], v[3]); o.z = cvt_pk_bf16(v[4], v[5]); o.w = cvt_pk_bf16(v[6], v[7]);
    *(u32x4*)(Wr + (size_t)r * 1024 + k0) = o;
}
__device__ __forceinline__ void misc_item(const float* const* in, float* misc, int tid) {
    for (int idx = tid; idx < 1024; idx += 512) { const int pos = idx >> 4, i = idx & 15; const float inv = exp2f(-(float)i * (13.287712379549449f / 16.f));
        float sn, c; sincosf((float)pos * inv, &sn, &c); misc[64 + idx] = c; misc[64 + 1024 + idx] = sn; }
    if (tid < 64) {
        const float s1 = wave_sum(in[10][tid] * in[11][tid]), s2 = wave_sum(in[12][tid] * in[13][tid]);
        float gq = fabsf(in[8][tid]), gk = fabsf(in[9][tid]);
#pragma unroll
        for (int o = 1; o < 64; o <<= 1) { gq = fmaxf(gq, __shfl_xor(gq, o)); gk = fmaxf(gk, __shfl_xor(gk, o)); }
        if (tid == 0) { misc[0] = expf(s1) - expf(s2) + LAM_INIT; misc[1] = 8.f * 1.4426950408889634f * gq * gk; }
    }
}
constexpr int IT_ADA = 192, IT_ST = 64, IT_WR = 64, IT_MISC = 1;
constexpr int IT0 = IT_ADA, IT1 = IT0 + IT_ST, IT2 = IT1 + IT_WR, IT_END = IT2 + IT_MISC;
constexpr int S5_ITEMS = 128;
__device__ __forceinline__ void s5_matrix_items(Frame& F, int first, int stride) {
    LAS float* L = (LAS float*)F.lds;
    for (int it = first; it < S5_ITEMS; it += stride) s5_item_lag(F.in, WSP(unsigned char, WS_S5W2), it, L, F.tid);
}
__device__ __forceinline__ void p0_prologue(Frame& F) {
    LAS float* L = (LAS float*)F.lds; const int tid = F.tid;
    for (int it = F.vcu; it < IT_END; it += F.G) {
        if (it < IT0) adaln_item(F.in[1], F.in[3], F.in[4], F.in[5], WSP(float, WS_MOD), it, L, tid);
        else if (it < IT1) s5_item_state(F.in, WSP(bf16_t, WS_S5W1), WSP(unsigned char, WS_S5W2), it - IT0, L, tid);
        else if (it < IT2) wr_item(F.in[27], F.in[29], WSP(bf16_t, WS_WR), it - IT1, tid);
        else misc_item(F.in, WSP(float, WS_MISC), tid);
    }
    __syncthreads();
    LAS float* scr = L + F.wave * 4096;
    const int gw = F.vcu * 8 + F.wave, NGW = F.G * 8;
    for (int it = gw; it < NTR_NONEXP; it += 2 * NGW) {
        const bool two = it + NGW < NTR_NONEXP;
        const TrItem t0 = tr_decode(F.in, F.ws, it); const TrItem t1 = tr_decode(F.in, F.ws, two ? it + NGW : it);
        f32x4 v0[8], v1[8];
        tr_load(t0, F.lane, v0); tr_load(t1, F.lane, v1);
        tr_store(t0, F.lane, v0, scr);
        if (two) tr_store(t1, F.lane, v1, scr);
    }
    __syncthreads();
}

__device__ __forceinline__ void tr_expert_slice(Frame& F, int k) {
    const int gw = F.vcu * 8 + F.wave, NGW = F.G * 8;
    const int it0 = NTR_NONEXP + (2 * k) * NGW + gw, it1 = it0 + NGW;
    if (it0 < NTR_ITEMS) {
        const bool two = it1 < NTR_ITEMS;
        const TrItem t0 = tr_decode(F.in, F.ws, it0); const TrItem t1 = tr_decode(F.in, F.ws, two ? it1 : it0);
        float v0[32], v1[32];
        tr8_load(t0, F.lane, v0); tr8_load(t1, F.lane, v1);
        tr8_store(t0, F.lane, v0);
        if (two) tr8_store(t1, F.lane, v1);
    }
}

__device__ __forceinline__ void norm_mod_rows(Frame& F, const float* xa, int na, const float* xb, int nbr, const float* gain, const float* mod, int sh_off, int sc_off, unsigned char* dst) {
    const int gw = F.vcu * 8 + F.wave, NGW = F.G * 8, lane = F.lane, total = na + nbr, per = (total + NGW - 1) / NGW;
    const int r0 = gw * per, r1 = (r0 + per < total) ? r0 + per : total;
    int curb = -1; f32x4 gm[4], sh[4];
#pragma unroll
    for (int j = 0; j < 4; ++j) { gm[j] = (f32x4){0.f, 0.f, 0.f, 0.f}; sh[j] = gm[j]; }
#pragma unroll 1
    for (int base = r0; base < r1; base += 4) {
        f32x4 v[4][4];
#pragma unroll
        for (int q = 0; q < 4; ++q) { const int row = base + q < r1 ? base + q : r1 - 1; const float* src = row < na ? xa + (size_t)row * 1024 : xb + (size_t)(row - na) * 1024;
#pragma unroll
            for (int j = 0; j < 4; ++j) v[q][j] = *(const f32x4*)(src + 4 * (lane + 64 * j)); }
#pragma unroll
        for (int q = 0; q < 4; ++q) { const int row = base + q;
            if (row < r1) {
                const int b = row < na ? row >> 12 : 16;
                if (b != curb) { curb = b; const float* mb = mod + (size_t)b * 6144;
#pragma unroll
                    for (int j = 0; j < 4; ++j) { const int k0 = 4 * (lane + 64 * j); const f32x4 gv = *(const f32x4*)(gain + k0), sc = *(const f32x4*)(mb + sc_off + k0); gm[j] = gv * (1.f + sc); sh[j] = *(const f32x4*)(mb + sh_off + k0); } }
                float ss = 0.f;
#pragma unroll
                for (int j = 0; j < 4; ++j) ss += v[q][j][0] * v[q][j][0] + v[q][j][1] * v[q][j][1] + v[q][j][2] * v[q][j][2] + v[q][j][3] * v[q][j][3];
                const float r = 1.f / sqrtf(wave_sum(ss) * (1.f / 1024.f) + RMS_EPS);
#pragma unroll
                for (int j = 0; j < 4; ++j) { const int k0 = 4 * (lane + 64 * j);
                    const f32x4 y = v[q][j] * r * gm[j] + sh[j];
                    int w = 0; w = __builtin_amdgcn_cvt_pk_fp8_f32(y[0], y[1], w, false); w = __builtin_amdgcn_cvt_pk_fp8_f32(y[2], y[3], w, true);
                    *(int*)(dst + (size_t)row * 1024 + k0) = w; }
            }
        }
    }
}

constexpr int RT_WPITCH = 2064;
constexpr int RT_TAB = 48 * RT_WPITCH;
constexpr int RT_LOG = RT_TAB + 8192;
constexpr int RT_CNT = RT_LOG + 8 * 2368;
constexpr int RT_CNT2 = RT_CNT + 512;
constexpr int RT_BIAS = RT_CNT2 + 896;
constexpr int RT_RES = LDSCTL_OFF + 2048;
static_assert(RT_CNT2 + 896 <= LDSCTL_OFF && RT_RES + 9216 <= LDS_BYTES && RT_RES >= MISC_OFF + 128, "router scratch must not touch the LDS control words");
__device__ __forceinline__ void norm2_router_phase(Frame& F, const bf16_t* x1b, const float* gain, const float* mod, bf16_t* Tb, const bf16_t* Wr, const float* brg, const float* bre, int* gcnt, int* ltok, float* lw, int* gcnt2, int* lrow, int* ptok) {
    LAS unsigned char* lds = F.lds; const int tid = F.tid, lane = F.lane, wave = F.wave, r = lane & 15, q = lane >> 4;
    typedef float f32x4_t __attribute__((ext_vector_type(4)));
    for (int blk = F.vcu; blk < T / 256; blk += F.G) {
        const int b = (blk * 256) >> 12; const float* mb = mod + (size_t)b * 6144;
        u32x4 raw[32];
        { const bf16_t* src0 = x1b + (size_t)(blk * 256 + wave * 32 + r) * 1024 + 8 * q;
#pragma unroll
          for (int st = 0; st < 32; ++st) raw[st] = *(const u32x4*)(src0 + 32 * st); }
        { u32x4 wv[12]; float tg[2], ts[2], th[2];
#pragma unroll
          for (int j = 0; j < 12; ++j) { const int idx = tid + j * 512, row = idx >> 7, c = idx & 127; wv[j] = *(const u32x4*)(Wr + (size_t)row * 1024 + c * 8); }
#pragma unroll
          for (int j = 0; j < 2; ++j) { const int idx = tid + j * 512; tg[j] = gain[idx]; ts[j] = mb[4096 + idx]; th[j] = mb[3072 + idx]; }
#pragma unroll
          for (int j = 0; j < 12; ++j) { const int idx = tid + j * 512, row = idx >> 7, c = idx & 127; *(LAS u32x4*)(lds + row * RT_WPITCH + c * 16) = wv[j]; }
#pragma unroll
          for (int j = 0; j < 2; ++j) { const int idx = tid + j * 512; ((LAS float*)(lds + RT_TAB))[idx] = tg[j] * (1.f + ts[j]); ((LAS float*)(lds + RT_TAB))[1024 + idx] = th[j]; } }
        if (tid >= 448 && tid < 484) { const int j = tid - 448; ((LAS float*)(lds + RT_BIAS))[j] = j < 4 ? brg[j] : bre[j - 4]; }
        if (tid < 128) ((LAS int*)(lds + RT_CNT))[tid] = 0;
        if (tid < 224) ((LAS int*)(lds + RT_CNT2))[tid] = 0;
        __syncthreads();
        LAS float* lg = (LAS float*)(lds + RT_LOG + wave * 2368);
        LAS int* cl = (LAS int*)(lds + RT_CNT); LAS int* cl2 = (LAS int*)(lds + RT_CNT2);
        LAS int* res = (LAS int*)(lds + RT_RES);
#pragma unroll
        for (int grp = 0; grp < 2; ++grp) {
            const int row = blk * 256 + wave * 32 + grp * 16 + r;
            const bf16_t* src = x1b + (size_t)row * 1024 + 8 * q; unsigned char* dst8 = (unsigned char*)Tb + (size_t)row * 1024 + 8 * q;
            if (grp == 1) {
#pragma unroll
                for (int st = 0; st < 32; ++st) raw[st] = *(const u32x4*)(src + 32 * st); }
            float ss = 0.f;
#pragma unroll
            for (int st = 0; st < 32; ++st) { const u32x4 v = raw[st];
                ss += bf_lo(v.x) * bf_lo(v.x) + bf_hi(v.x) * bf_hi(v.x) + bf_lo(v.y) * bf_lo(v.y) + bf_hi(v.y) * bf_hi(v.y) + bf_lo(v.z) * bf_lo(v.z) + bf_hi(v.z) * bf_hi(v.z) + bf_lo(v.w) * bf_lo(v.w) + bf_hi(v.w) * bf_hi(v.w); }
            ss += __shfl_xor(ss, 16); ss += __shfl_xor(ss, 32);
            const float rn = 1.f / sqrtf(ss * (1.f / 1024.f) + RMS_EPS);
#pragma unroll
            for (int st = 0; st < 32; ++st) asm volatile("" : "+v"(raw[st]));
            f32x4_t acc0 = {0.f, 0.f, 0.f, 0.f}, acc1 = {0.f, 0.f, 0.f, 0.f}, acc2 = {0.f, 0.f, 0.f, 0.f};
            int qo = q, ro = r; asm volatile("" : "+v"(qo), "+v"(ro));
            const LAS unsigned char* tabp = lds + RT_TAB + 32 * qo; const LAS unsigned char* wp = lds + ro * RT_WPITCH + 16 * qo; const LAS unsigned char* wp2 = wp + 32 * RT_WPITCH;
#pragma unroll
            for (int st = 0; st < 32; ++st) { const u32x4 v = raw[st];
                const f32x4 g0 = *(const LAS f32x4*)(tabp + 128 * st), g1 = *(const LAS f32x4*)(tabp + 128 * st + 16), h0 = *(const LAS f32x4*)(tabp + 4096 + 128 * st), h1 = *(const LAS f32x4*)(tabp + 4096 + 128 * st + 16);
                const float y0 = bf_lo(v.x) * rn * g0[0] + h0[0], y1 = bf_hi(v.x) * rn * g0[1] + h0[1], y2 = bf_lo(v.y) * rn * g0[2] + h0[2], y3 = bf_hi(v.y) * rn * g0[3] + h0[3];
                const float y4 = bf_lo(v.z) * rn * g1[0] + h1[0], y5 = bf_hi(v.z) * rn * g1[1] + h1[1], y6 = bf_lo(v.w) * rn * g1[2] + h1[2], y7 = bf_hi(v.w) * rn * g1[3] + h1[3];
                u32x4 o; o.x = cvt_pk_bf16(y0, y1); o.y = cvt_pk_bf16(y2, y3); o.z = cvt_pk_bf16(y4, y5); o.w = cvt_pk_bf16(y6, y7);
                { int w0 = 0, w1 = 0;
                  w0 = __builtin_amdgcn_cvt_pk_fp8_f32(y0, y1, w0, false); w0 = __builtin_amdgcn_cvt_pk_fp8_f32(y2, y3, w0, true);
                  w1 = __builtin_amdgcn_cvt_pk_fp8_f32(y4, y5, w1, false); w1 = __builtin_amdgcn_cvt_pk_fp8_f32(y6, y7, w1, true);
                  u32x2 o8; o8.x = (unsigned)w0; o8.y = (unsigned)w1; *(u32x2*)(dst8 + 32 * st) = o8; }
                const bf16x8 af = __builtin_bit_cast(bf16x8, o);
                const bf16x8 b0 = *(const LAS bf16x8*)(wp + 64 * st), b1 = *(const LAS bf16x8*)(wp + 16 * RT_WPITCH + 64 * st), b2 = *(const LAS bf16x8*)(wp2 + 64 * st);
                acc0 = __builtin_amdgcn_mfma_f32_16x16x32_bf16(af, b0, acc0, 0, 0, 0); acc1 = __builtin_amdgcn_mfma_f32_16x16x32_bf16(af, b1, acc1, 0, 0, 0); acc2 = __builtin_amdgcn_mfma_f32_16x16x32_bf16(af, b2, acc2, 0, 0, 0);
                if ((st & 3) == 3) __builtin_amdgcn_sched_barrier(0); }
#pragma unroll
            for (int i = 0; i < 4; ++i) { lg[(4 * q + i) * 37 + r] = acc0[i]; lg[(4 * q + i) * 37 + 16 + r] = acc1[i]; if (r < 4) lg[(4 * q + i) * 37 + 32 + r] = acc2[i]; }
            asm volatile("s_waitcnt lgkmcnt(0)" ::: "memory");
            int e0 = 0, e1 = 0, r0 = 0, r1 = 0, pg = 0, rpp = 0, h0 = 0; float w0 = 0.f, w1 = 0.f;
            if (lane < 16) {
                const LAS float* lr = lg + lane * 37; const LAS float* bl = (const LAS float*)(lds + RT_BIAS);
                float gl[4]; int gi = 0; float gm;
#pragma unroll
                for (int j = 0; j < 4; ++j) gl[j] = lr[j] + bl[j];
                gm = gl[0];
#pragma unroll
                for (int j = 1; j < 4; ++j) if (gl[j] > gm) { gm = gl[j]; gi = j; }
                float den = 0.f;
#pragma unroll
                for (int j = 0; j < 4; ++j) den += __expf(gl[j] - gm);
                const float pgrp = 1.f / den;
                float v1 = -3.0e38f, v2 = -3.0e38f; int i1 = 0, i2 = 0;
                for (int j = 0; j < 8; ++j) { const float v = lr[4 + gi * 8 + j] + bl[4 + gi * 8 + j];
                    if (v > v1) { v2 = v1; i2 = i1; v1 = v; i1 = j; } else if (v > v2) { v2 = v; i2 = j; } }
                const float ex = __expf(v2 - v1); w0 = pgrp / (1.f + ex); w1 = pgrp * ex / (1.f + ex);
                e0 = gi * 8 + i1; e1 = 32 + gi * 8 + i2;
                r0 = atomicAdd((int*)&cl[e0], 1); r1 = atomicAdd((int*)&cl[e1], 1);
                { const int a = i1 < i2 ? i1 : i2, b = i1 < i2 ? i2 : i1; pg = gi * 28 + (a * 8 - (a * (a + 1)) / 2) + (b - a - 1); h0 = i1 < i2 ? 0 : 1; rpp = atomicAdd((int*)&cl2[pg], 1); }
            }
            if (lane < 16) { LAS int* rp = res + ((wave * 2 + grp) * 16 + lane) * 9; rp[0] = e0; rp[1] = e1; rp[2] = r0; rp[3] = r1; rp[4] = __builtin_bit_cast(int, w0); rp[5] = __builtin_bit_cast(int, w1); rp[6] = pg; rp[7] = rpp; rp[8] = h0; }
            asm volatile("s_waitcnt lgkmcnt(0)" ::: "memory");
        }
        __syncthreads();
        if (tid < 64) { const int n = cl[tid]; cl[64 + tid] = n > 0 ? atomicAdd(&gcnt[tid], n) : 0; }
        else if (tid < 64 + NPAIR) { const int q_ = tid - 64; const int n = cl2[q_]; cl2[NPAIR + q_] = n > 0 ? atomicAdd(&gcnt2[q_], n) : 0; }
        __syncthreads();
        if (lane < 16) {
#pragma unroll
            for (int grp = 0; grp < 2; ++grp) { const LAS int* rp = res + ((wave * 2 + grp) * 16 + lane) * 9; const int e0 = rp[0], e1 = rp[1];
                const int tok = blk * 256 + wave * 32 + grp * 16 + lane; const int p0 = cl[64 + e0] + rp[2], p1 = cl[64 + e1] + rp[3];
                ltok[e0 * LISTCAP + p0] = tok; lw[e0 * LISTCAP + p0] = __builtin_bit_cast(float, rp[4]); ltok[e1 * LISTCAP + p1] = tok; lw[e1 * LISTCAP + p1] = __builtin_bit_cast(float, rp[5]);
                const int pgx = rp[6], ppos = cl2[NPAIR + pgx] + rp[7], hs = rp[8];
                lrow[e0 * LISTCAP + p0] = (pgx << 17) | (ppos << 1) | hs; lrow[e1 * LISTCAP + p1] = (pgx << 17) | (ppos << 1) | (1 - hs); ptok[pgx * LISTCAP + ppos] = tok; }
        }
        __syncthreads();
    }
}

__device__ __forceinline__ void s5_scan_phase(Frame& F) {
    if (F.vcu * 512 >= NB * SG * 2 * 64) return;
    const int gt = F.vcu * 512 + F.tid;
    const int p = gt & 63, dir = (gt >> 6) & 1, g = (gt >> 7) & 31, b = gt >> 12, pair = F.tid >> 7;
    float lr, li, cr, ci; s5_disc(F.in[15], F.in[16], F.in[17], dir, g, p, lr, li, cr, ci);
#pragma unroll
    for (int e = 0; e < 5; ++e) { const float t = lr * lr - li * li; li = 2.f * lr * li; lr = t; }
    const unsigned* Sb = WSP(unsigned, WS_SB) + (size_t)g * A2_ROWS * 128 + dir * 64 + p;
    LAS unsigned char* stg = F.lds + pair * 32768 + dir * 128 + p;
    float hr = 0.f, hi = 0.f;
    for (int c = 0; c < 8; ++c) { const int row = A2_LAT + b * 8 + (dir == 0 ? c : 7 - c);
        const unsigned w = Sb[(size_t)row * 128]; const float sr = __uint_as_float(w << 16), si = __uint_as_float(w & 0xffff0000u);
        const float t = lr * hr - li * hi + sr; hi = lr * hi + li * hr + si; hr = t; }
#pragma unroll 1
    for (int c0 = 0; c0 < 128; c0 += 32) {
        unsigned sw[32];
#pragma unroll
        for (int q = 0; q < 32; ++q) { const int c = c0 + q; const int row = b * 128 + (dir == 0 ? c : 127 - c); sw[q] = Sb[(size_t)row * 128]; }
#pragma unroll
        for (int q = 0; q < 32; ++q) { const int c = c0 + q; const int cc = dir == 0 ? c : 127 - c;
            { const int w = __builtin_amdgcn_cvt_pk_fp8_f32(hr, hi, 0, false); stg[cc * 256] = (unsigned char)(w & 0xff); stg[cc * 256 + 64] = (unsigned char)((w >> 8) & 0xff); }
            const float sr = __uint_as_float(sw[q] << 16), si = __uint_as_float(sw[q] & 0xffff0000u);
            const float t = lr * hr - li * hi + sr; hi = lr * hi + li * hr + si; hr = t; }
    }
    __syncthreads();
    { const int t = F.tid & 127; unsigned char* dstb = WSP(unsigned char, WS_A28) + ((size_t)g * A2_ROWS + b * 128) * 768 + 512 + (t & 15) * 16;
      const LAS unsigned char* srcb = F.lds + pair * 32768 + (t & 15) * 16;
#pragma unroll
      for (int it = 0; it < 16; ++it) { const int row = it * 8 + (t >> 4); *(u32x4*)(dstb + (size_t)row * 768) = *(const LAS u32x4*)(srcb + row * 256); } }
}

constexpr int ATT_NT = KV / 64;
constexpr float ATT_PBIAS = 44.f;
constexpr int ATT_SLOT = 8192;
constexpr int ATT_VB = 8 * ATT_SLOT;
constexpr int ATT_W = 3, ATT_PK = ATT_W + 2, ATT_PVD = ATT_W + 1;
typedef int v8i __attribute__((ext_vector_type(8)));
typedef int v4i __attribute__((ext_vector_type(4)));
__device__ __forceinline__ void attn_phase(Frame& F) {
    const int lane = F.lane, wid = F.wave, cmap = wid >> 2, qs = wid & 3, r32 = lane & 31, hh = lane >> 5;
    LAS unsigned char* lds = F.lds;
    const unsigned char* Q8 = WSP(unsigned char, WS_Q); const unsigned char* K8 = WSP(unsigned char, WS_K); const unsigned char* V8 = WSP(unsigned char, WS_VT); bf16_t* AO = WSP(bf16_t, WS_AO);
    const float* misc = WSP(float, WS_MISC); const float lam = misc[0];
    LAS float* sublnL = (LAS float*)(lds + LDSCTL_OFF + 2048);
    if (F.tid < 128) sublnL[F.tid] = F.in[14][F.tid];
    __syncthreads();
    const int krow = 8 * wid + (lane >> 3), kgo = krow * 512 + (((lane & 7) ^ ((krow >> 1) & 7)) * 16);
    const int vrow = 16 * wid + (lane >> 2), vgo = vrow * KV + (((lane & 3) ^ ((vrow >> 2) & 3)) * 16);
    const int ldw = wid * 1024;
    const int kp = 32 * ((r32 >> 2) & 1) + 4 * (r32 >> 3) + (r32 & 3), swk = (kp >> 1) & 7, swv = (r32 >> 2) & 3;
    const int koff0 = kp * 128 + (((4 * cmap + 2 * hh) ^ swk) * 16), koff1 = kp * 128 + (((4 * cmap + 2 * hh + 1) ^ swk) * 16);
    const int voff0 = ATT_VB + r32 * 64 + (((2 * hh) ^ swv) * 16), voff1 = ATT_VB + r32 * 64 + (((2 * hh + 1) ^ swv) * 16);
    LAS float* Lf = (LAS float*)lds;
    int sc_one = 0x7f7f7f7f, sc_q = 0x7d7d7d7d, sc_v = 0x7c7c7c7c;
    f32x16 cbias;
#pragma unroll
    for (int r = 0; r < 16; ++r) cbias[r] = ATT_PBIAS;
    asm volatile("" : "+v"(cbias));
    asm volatile("" : "+v"(sc_one), "+v"(sc_q), "+v"(sc_v));
    const int selw = (((lane & 15) == 0 || (lane & 15) == 8) && !((lane >> 4) & 1)) || (((lane & 15) == 4 || (lane & 15) == 12) && ((lane >> 4) & 1)) ? 0x38383838 : 0;
    v8i ones = {selw, selw, selw, selw, selw, selw, selw, selw};
    asm volatile("" : "+v"(ones));
    if (cmap == 1) __builtin_amdgcn_s_setprio(1);
#define ATT_DMA(gp, off) __builtin_amdgcn_global_load_lds((const unsigned*)(gp), (LAS unsigned*)(lds + (off) + ldw), 16, 0, 0)
#define ATT_LDK(dst, sb, blk) do { dst.lo = *(const LAS v4i*)(lds + (sb) + koff0 + (blk) * 2048); dst.hi = *(const LAS v4i*)(lds + (sb) + koff1 + (blk) * 2048); } while (0)
#define ATT_LDV(dst, sb, d) do { dst.lo = *(const LAS v4i*)(lds + (sb) + voff0 + (d) * 2048); dst.hi = *(const LAS v4i*)(lds + (sb) + voff1 + (d) * 2048); } while (0)
#define ATT_QK(dst, kfr) asm volatile("v_mfma_scale_f32_32x32x64_f8f6f4 %0, %1, %2, %3, %4, %5 op_sel_hi:[0,0,0]" : "=&v"(dst) : "v"(kfr), "v"(Qf), "v"(cbias), "v"(sc_one), "v"(sc_q))
#define ATT_PV(acc, vfr, Pc) asm volatile("v_mfma_scale_f32_32x32x64_f8f6f4 %0, %1, %2, %0, %3, %4 op_sel_hi:[0,0,0] blgp:1" : "+v"(acc) : "v"(vfr), "v"(Pc), "v"(sc_v), "v"(sc_one))
#define ATT_PL(Pc) asm volatile("v_mfma_scale_f32_16x16x128_f8f6f4 %0, %1, %2, %0, %3, %3 op_sel_hi:[0,0,0] blgp:1" : "+v"(L) : "v"(ones), "v"(Pc), "v"(sc_one))
#define ATT_EXP8(S, base) do { } while (0)
#define ATT_PK4(old, S, i) (int)__builtin_amdgcn_cvt_pk_u8_f32(S[(i) + 3], 3, __builtin_amdgcn_cvt_pk_u8_f32(S[(i) + 2], 2, __builtin_amdgcn_cvt_pk_u8_f32(S[(i) + 1], 1, __builtin_amdgcn_cvt_pk_u8_f32(S[i], 0, (unsigned)(old)))))
#define ATT_PACK0(Pn) do { Pn[0] = ATT_PK4(Pn[0], sc0, 0); Pn[1] = ATT_PK4(Pn[1], sc0, 4); Pn[2] = ATT_PK4(Pn[2], sc0, 8); Pn[3] = ATT_PK4(Pn[3], sc0, 12); } while (0)
#define ATT_PACK1(Pn) do { Pn[4] = ATT_PK4(Pn[4], sc1, 0); Pn[5] = ATT_PK4(Pn[5], sc1, 4); Pn[6] = ATT_PK4(Pn[6], sc1, 8); Pn[7] = ATT_PK4(Pn[7], sc1, 12); } while (0)
#define SB() __builtin_amdgcn_sched_barrier(0)
    int it = 0;
    for (;; ++it) {
        const int unit = it * F.G + F.vcu; if (unit >= NB * 4 * 32) break;
        const int b = unit >> 7, h = (unit >> 5) & 3, qb = unit & 31;
        size_t qrow = (size_t)b * SEQ + qb * 128 + qs * 32 + r32;
        const unsigned char* Kg = K8 + (size_t)b * KV * 512 + h * 128; const unsigned char* Vg = V8 + (size_t)(b * 4 + h) * 128 * KV;
#pragma unroll
        for (int j = 0; j < ATT_PK; ++j) ATT_DMA(Kg + j * (64 * 512) + kgo, j * ATT_SLOT);
#pragma unroll
        for (int j = 0; j < ATT_PVD; ++j) ATT_DMA(Vg + j * 64 + vgo, ATT_VB + j * ATT_SLOT);
        v8i Qf; { const unsigned char* qp = Q8 + qrow * 512 + h * 128 + cmap * 64 + hh * 32; Qf.lo = *(const v4i*)qp; Qf.hi = *(const v4i*)(qp + 16); }
        asm volatile("s_waitcnt vmcnt(0)\n\ts_barrier" ::: "memory");
        v8i kf0, kf1, vf0, vf1, vf2, vf3;
        ATT_LDK(kf0, 0, 0); ATT_LDK(kf1, 0, 1);
        f32x16 O[4];
#pragma unroll
        for (int d = 0; d < 4; ++d)
#pragma unroll
            for (int r = 0; r < 16; ++r) O[d][r] = 0.f;
        f32x4 L = {0.f, 0.f, 0.f, 0.f};
        f32x16 sc0, sc1; v8i Pv = {0, 0, 0, 0, 0, 0, 0, 0};
        ATT_DMA(Kg + (size_t)ATT_PK * (64 * 512) + kgo, (ATT_PK & 7) * ATT_SLOT); ATT_DMA(Vg + ATT_PVD * 64 + vgo, ATT_VB + ATT_PVD * ATT_SLOT);
        asm volatile("s_waitcnt lgkmcnt(0)" ::: "memory");
        ATT_QK(sc0, kf0); ATT_QK(sc1, kf1);
        asm volatile("s_nop 15\n\ts_nop 15\n\ts_nop 15" ::: "memory"); SB();
        ATT_LDK(kf0, ATT_SLOT, 0); ATT_LDK(kf1, ATT_SLOT, 1);
        ATT_LDV(vf0, 0, 0); ATT_LDV(vf1, 0, 1); ATT_LDV(vf2, 0, 2); ATT_LDV(vf3, 0, 3);
        ATT_EXP8(sc0, 0); ATT_EXP8(sc0, 8); ATT_EXP8(sc1, 0); ATT_EXP8(sc1, 8);
        ATT_PACK0(Pv); ATT_PACK1(Pv); SB();
        asm volatile("s_waitcnt lgkmcnt(0)" ::: "memory");
        ATT_QK(sc0, kf0); ATT_QK(sc1, kf1);
        asm volatile("s_waitcnt vmcnt(%0) lgkmcnt(0)\n\ts_barrier" :: "n"(2 * ATT_W) : "memory");
#define ATT_TILE(t_, BAR) do { \
            const int tk = (t_) + ATT_PK < ATT_NT ? (t_) + ATT_PK : ATT_NT - 1, tv = (t_) + ATT_PVD < ATT_NT ? (t_) + ATT_PVD : ATT_NT - 1; \
            const int ks_wr = (((t_) + ATT_PK) & 7) * ATT_SLOT, ks_rd = (((t_) + 1) & 7) * ATT_SLOT, vs_rd = ((t_) & 7) * ATT_SLOT, vs_wr = (((t_) + ATT_PVD) & 7) * ATT_SLOT; \
            ATT_DMA(Kg + (size_t)tk * (64 * 512) + kgo, ks_wr); ATT_DMA(Vg + tv * 64 + vgo, ATT_VB + vs_wr); SB(); \
            ATT_PV(O[0], vf0, Pv); SB(); \
            ATT_LDV(vf0, vs_rd, 0); ATT_LDK(kf0, ks_rd, 0); SB(); \
            ATT_PV(O[1], vf1, Pv); SB(); \
            ATT_LDV(vf1, vs_rd, 1); ATT_LDK(kf1, ks_rd, 1); SB(); \
            ATT_PV(O[2], vf2, Pv); SB(); \
            ATT_LDV(vf2, vs_rd, 2); SB(); \
            ATT_PV(O[3], vf3, Pv); ATT_PL(Pv); SB(); \
            ATT_PACK0(Pv); SB();                      \
            ATT_QK(sc0, kf0); SB(); \
            ATT_LDV(vf3, vs_rd, 3); ATT_PACK1(Pv); SB(); \
            ATT_QK(sc1, kf1); \
            if (BAR) asm volatile("s_waitcnt vmcnt(%0) lgkmcnt(0)\n\ts_barrier" :: "n"(2 * ATT_W - 2) : "memory"); } while (0)
#pragma unroll 1
        for (int t = 1; t < ATT_NT - 1; t += 2) { ATT_TILE(t, 0); ATT_TILE(t + 1, 1); }
        ATT_TILE(ATT_NT - 1, 1);
        ATT_PV(O[0], vf0, Pv); ATT_PV(O[1], vf1, Pv); ATT_PV(O[2], vf2, Pv); ATT_PV(O[3], vf3, Pv); ATT_PL(Pv);
        asm volatile("s_nop 15\n\ts_nop 15\n\ts_waitcnt vmcnt(0)\n\ts_barrier" ::: "memory");
        { int r32o = F.lane & 31; asm volatile("" : "+v"(r32o)); qrow = (size_t)b * SEQ + qb * 128 + qs * 32 + r32o; }
        const int tr_gw = F.vcu * 8 + F.wave, tr_ngw = F.G * 8, tr_i0 = NTR_NONEXP + (2 * it) * tr_ngw + tr_gw, tr_i1 = tr_i0 + tr_ngw;
        const bool tr_has = tr_i0 < NTR_ITEMS, tr_two = tr_i1 < NTR_ITEMS;
        const TrItem tr_t0 = tr_decode(F.in, F.ws, tr_has ? tr_i0 : NTR_NONEXP), tr_t1 = tr_decode(F.in, F.ws, tr_two ? tr_i1 : NTR_NONEXP);
        float tr_v0[32], tr_v1[32];
        tr8_load(tr_t0, lane, tr_v0); tr8_load(tr_t1, lane, tr_v1);
        const float inv = 1.f / L[0];
        LAS float* SS = Lf + 16384;
#define ATT_SEND(d, slot) do { _Pragma("unroll") for (int r = 0; r < 16; ++r) Lf[(slot) * 8192 + ((qs * 2 + ((d) & 1)) * 16 + r) * 64 + lane] = O[d][r] * inv; } while (0)
        if (cmap == 0) { ATT_SEND(2, 1); ATT_SEND(3, 1); } else { ATT_SEND(0, 0); ATT_SEND(1, 0); }
        __syncthreads();
        float ss = 0.f;
#define ATT_COMB0(d) do { _Pragma("unroll") for (int r = 0; r < 16; ++r) { const float o = O[d][r] * inv - lam * Lf[((qs * 2 + ((d) & 1)) * 16 + r) * 64 + lane]; O[d][r] = o; ss += o * o; } } while (0)
#define ATT_COMB1(d) do { _Pragma("unroll") for (int r = 0; r < 16; ++r) { const float o = Lf[8192 + ((qs * 2 + ((d) & 1)) * 16 + r) * 64 + lane] - lam * (O[d][r] * inv); O[d][r] = o; ss += o * o; } } while (0)
        if (cmap == 0) { ATT_COMB0(0); ATT_COMB0(1); } else { ATT_COMB1(2); ATT_COMB1(3); }
        ss += __shfl_xor(ss, 32);
        if (hh == 0) SS[(cmap * 4 + qs) * 32 + r32] = ss;
        __syncthreads();
        ss += SS[((1 - cmap) * 4 + qs) * 32 + r32];
        const float rn = (1.f - LAM_INIT) / sqrtf(ss * (1.f / 128.f) + RMS_EPS);
#define ATT_STORE(d) do { _Pragma("unroll") for (int gp = 0; gp < 2; ++gp) { \
            const f32x4 sge = *(const LAS f32x4*)(sublnL + 32 * (d) + 16 * gp + 4 * hh), sgo = *(const LAS f32x4*)(sublnL + 32 * (d) + 16 * gp + 8 + 4 * hh); \
            const unsigned ex = cvt_pk_bf16(O[d][8 * gp] * rn * sge[0], O[d][8 * gp + 1] * rn * sge[1]), ey = cvt_pk_bf16(O[d][8 * gp + 2] * rn * sge[2], O[d][8 * gp + 3] * rn * sge[3]); \
            const unsigned ox = cvt_pk_bf16(O[d][8 * gp + 4] * rn * sgo[0], O[d][8 * gp + 5] * rn * sgo[1]), oy = cvt_pk_bf16(O[d][8 * gp + 6] * rn * sgo[2], O[d][8 * gp + 7] * rn * sgo[3]); \
            const u32x2 rx = __builtin_amdgcn_permlane32_swap(ex, ox, false, false), ry = __builtin_amdgcn_permlane32_swap(ey, oy, false, false); \
            u32x4 w; w.x = rx[0]; w.y = ry[0]; w.z = rx[1]; w.w = ry[1]; \
            *(u32x4*)(AO + qrow * 1024 + h * 128 + 32 * (d) + 8 * (2 * gp + hh)) = w; } } while (0)
        if (cmap == 0) { ATT_STORE(0); ATT_STORE(1); } else { ATT_STORE(2); ATT_STORE(3); }
#undef ATT_SEND
#undef ATT_COMB0
#undef ATT_COMB1
#undef ATT_STORE
        if (tr_has) tr8_store(tr_t0, lane, tr_v0);
        if (tr_two) tr8_store(tr_t1, lane, tr_v1);
        __syncthreads();
    }
    for (; it < 8; ++it) tr_expert_slice(F, it);
    __builtin_amdgcn_s_setprio(0);
#undef ATT_DMA
#undef ATT_LDK
#undef ATT_LDV
#undef ATT_QK
#undef ATT_PV
#undef ATT_EXP8
#undef ATT_PK4
#undef ATT_SUM8
#undef ATT_PACK0
#undef ATT_PACK1
#undef ATT_TILE
#undef ATT_PL
#undef SB
}

constexpr int NPHASE = 15;
__device__ __forceinline__ void moe_prefix(Frame& F) {
    LAS int* toff = (LAS int*)(F.lds + LDSCTL_OFF);
    const int* gcnt = (const int*)(F.ws + WS_CTL) + CW_CNT;
    __syncthreads();
    if (F.tid < 64) { const int lane = F.tid; const int cnt = gcnt[lane]; toff[2304 + lane] = cnt; const int n = (cnt + 255) >> 8; int v = n;
#pragma unroll
        for (int o = 1; o < 64; o <<= 1) { const int t = __shfl_up(v, o); if (lane >= o) v += t; }
        toff[lane] = v - n; if (lane == 63) toff[64] = v; }
    else if (F.tid < 128) { LAS int* toff2 = toff + 128; const int* gcnt2 = gcnt + 64; const int lane = F.tid - 64;
        const int c0 = gcnt2[lane], c1 = (64 + lane < NPAIR) ? gcnt2[64 + lane] : 0; toff[2432 + lane] = c0; toff[2432 + 64 + lane] = c1;
        const int n0 = (c0 + 255) >> 8, n1 = (c1 + 255) >> 8; int v0 = n0, v1 = n1;
#pragma unroll
        for (int o = 1; o < 64; o <<= 1) { const int t0 = __shfl_up(v0, o), t1 = __shfl_up(v1, o); if (lane >= o) { v0 += t0; v1 += t1; } }
        const int tot0 = __shfl(v0, 63), tot1 = __shfl(v1, 63);
        toff2[lane] = v0 - n0; if (64 + lane < NPAIR) toff2[64 + lane] = tot0 + v1 - n1; if (lane == 0) toff2[NPAIR] = tot0 + tot1; }
    __syncthreads();
    { LAS unsigned short* tmap = (LAS unsigned short*)(toff + 1024); LAS unsigned short* tmap2 = (LAS unsigned short*)(toff + 1536); const LAS int* toff2 = toff + 128;
      for (int t = F.tid; t < toff[64]; t += 512) { int lo = 0, hi = 64; while (hi - lo > 1) { const int mid = (lo + hi) >> 1; if (toff[mid] <= t) lo = mid; else hi = mid; } tmap[t] = (unsigned short)lo; }
      for (int t = F.tid; t < toff2[NPAIR]; t += 512) { int lo = 0, hi = NPAIR; while (hi - lo > 1) { const int mid = (lo + hi) >> 1; if (toff2[mid] <= t) lo = mid; else hi = mid; } tmap2[t] = (unsigned short)lo; } }
    __syncthreads();
}
__global__ void __launch_bounds__(512, 2) fwd_kernel(Args args) {
    extern __shared__ __attribute__((aligned(16))) unsigned char lds_raw[];
    Frame F;
    F.lds = (LAS unsigned char*)lds_raw;
    F.tid = threadIdx.x; F.lane = F.tid & 63; F.wave = __builtin_amdgcn_readfirstlane(F.tid >> 6);
    F.G = gridDim.x; { const int bx = blockIdx.x; F.vcu = (F.G % 8 == 0) ? (bx % 8) * (F.G / 8) + bx / 8 : bx; }
    F.in = args.in; F.out = args.out; F.ws = args.ws;
    volatile LAS unsigned* MISC = (volatile LAS unsigned*)(F.lds + MISC_OFF);
    for (int u = F.tid; u < (LDS_BYTES - LDSCTL_OFF) / 4; u += 512) ((LAS unsigned*)(F.lds + LDSCTL_OFF))[u] = 0u;
    __syncthreads();
    const int lo = args.ph_lo, hi = args.ph_hi;
    XcdBarrier bar; bar.bar = (unsigned*)(F.ws + WS_CTL) + CW_BAR; bar.x = 0; bar.st = nullptr;
    if (hi - lo > 1) bar = xcd_barrier_post((unsigned*)(F.ws + WS_CTL) + CW_BAR, MISC + 8);
#define IN(k) (lo <= (k) && (k) < hi)
#define SEAM(k) do { if (IN(k) && IN((k) + 1)) xcd_barrier(bar); } while (0)
#define WSB_ ((const char*)F.ws)
#define MOD_ WSP(float, WS_MOD)
#define GCNT_ ((int*)(F.ws + WS_CTL) + CW_CNT)
#define LTOK_ WSP(int, WS_LTOK)
#define LWP_ WSP(float, WS_LW)
#define TOFF_ ((LAS int*)(F.lds + LDSCTL_OFF))

    if (IN(0)) { p0_prologue(F); } SEAM(0);
    if (IN(1)) { norm_mod_rows(F, F.in[0], T, F.in[2], TC, F.in[6], MOD_, 0, 1024, WSP(unsigned char, WS_XN)); } SEAM(1);
    if (IN(2)) { pg8::Gemm g{512, 512, 512};         SchedInProj S{WSB_ + WS_XN, WSB_ + WS_WQKU, WSB_ + WS_WV, F.G, F.vcu};
        { const f32x4 rv = *(const f32x4*)(WSP(float, WS_MISC) + 64 + F.tid * 4); *(LAS f32x4*)(F.lds + LDSCTL_OFF + 4096 + F.tid * 16) = rv;
          if (F.tid < 128) ((LAS float*)(F.lds + LDSCTL_OFF + 12288))[F.tid] = F.tid < 64 ? F.in[8][F.tid] : F.in[9][F.tid - 64];        __syncthreads(); }
        EpiInProj E{WSP(unsigned char, WS_Q), WSP(unsigned char, WS_K), WSP(bf16_t, WS_A2), WSP(unsigned char, WS_A28), WSP(unsigned char, WS_VT), (const LAS float*)(F.lds + LDSCTL_OFF + 12288), (const LAS float*)(F.lds + LDSCTL_OFF + 12288) + 64, (const LAS float*)(F.lds + LDSCTL_OFF + 4096)};
        pg8::gemm_phase<EpiInProj, SchedInProj, true, true>(F.lds, g, S, E);
        { const int full = 2144 / F.G, rem = 2144 % F.G;
          if (F.vcu >= rem && rem > 0) s5_matrix_items(F, F.vcu - rem, F.G - rem); else if (rem == 0) s5_matrix_items(F, F.vcu, F.G); (void)full; } } SEAM(2);
    if (IN(4)) {
        { pg8::Gemm g{A2_LD, 512, 512}; SchedS5 S{WSB_ + WS_A2, WSB_ + WS_S5W1, 512, 256, 9, 1, 288, F.G, F.vcu, (size_t)A2_ROWS * A2_LD * 2}; EpiS5State E{WSP(unsigned, WS_SB)};
          pg8::gemm_phase<EpiS5State, SchedS5, true>(F.lds, g, S, E); }
        attn_phase(F); } SEAM(4);
    if (IN(5)) { s5_scan_phase(F); } SEAM(5);
    if (IN(7)) { pg8::Gemm g{384, 384, 384};        SchedS5 S{WSB_ + WS_A28, WSB_ + WS_S5W2, 384, 512, 8, 2, 512, F.G, F.vcu, (size_t)A2_ROWS * 768}; EpiS5Out E{WSP(unsigned char, WS_YG)};
        pg8::gemm_phase<EpiS5Out, SchedS5, true, true>(F.lds, g, S, E); } SEAM(7);
    if (IN(8)) { pg8::Gemm g{256, 256, 256};        SchedGrid S{WSB_ + WS_YG, WSB_ + WS_WGLU, 256, 2, 512, F.G, F.vcu}; EpiGlu E{WSP(unsigned char, WS_YG), F.in[24], WSP(bf16_t, WS_AO)};
        pg8::gemm_phase<EpiGlu, SchedGrid, true, true>(F.lds, g, S, E); } SEAM(8);
    if (IN(9)) { pg8::Gemm g{1024, 1024, 1024}; SchedGrid S{WSB_ + WS_AO, WSB_ + WS_WOUT, 1024, 4, 1024, F.G, F.vcu}; EpiOut E{F.in[0], MOD_, WSP(bf16_t, WS_X1B)};
        pg8::gemm_phase<EpiOut, SchedGrid, true>(F.lds, g, S, E); } SEAM(9);
    if (IN(10)) { norm2_router_phase(F, WSP(bf16_t, WS_X1B), F.in[26], MOD_, WSP(bf16_t, WS_T8), WSP(bf16_t, WS_WR), F.in[28], F.in[30], GCNT_, LTOK_, LWP_, GCNT_ + 64, WSP(int, WS_LROW), WSP(int, WS_PTOK)); } SEAM(10);
    if (IN(12)) { moe_prefix(F); pg8::Gemm g{512, 512, 512};
        SchedMoe S{WSB_ + WS_T8, WSB_ + WS_WGU, TOFF_, GCNT_, LTOK_, 0, 64, 4, 512, 1024, 1, F.G, F.vcu}; EpiGateUp E{F.ws + WS_H, GCNT_, LWP_, WSP(int, WS_LROW), TOFF_ + 128, F.ws + WS_TRASH};
        pg8::gemm_phase<EpiGateUp, SchedMoe, true, true>(F.lds, g, S, E); } SEAM(12);
    if (IN(13)) { moe_prefix(F); pg8::Gemm g{512, 256, 512};
        SchedPair S{WSB_ + WS_H, WSB_ + WS_WD, TOFF_ + 128, F.G, F.vcu}; EpiDown2 E{GCNT_ + 64, WSP(int, WS_PTOK), MOD_, WSP(bf16_t, WS_X1B), F.out, F.ws + WS_TRASH, TOFF_ + 2432};
        pg8::gemm_phase<EpiDown2, SchedPair, true, true, true>(F.lds, g, S, E); }
#undef IN
#undef SEAM
#undef WSB_
#undef MOD_
#undef GCNT_
#undef LTOK_
#undef LWP_
#undef TOFF_
}

extern "C" void kernel_launch(void* const* d_in, const int* in_sizes, int n_in, void* d_out, int out_size, void* d_ws, size_t ws_size, hipStream_t stream) {
    static int grid = 0;
    if (grid == 0) {
        if (n_in != 34 || out_size != T * DM || ws_size < WS_END) { fprintf(stderr, "kernel_launch: unexpected shapes (n_in %d out %d ws %zu)\n", n_in, out_size, ws_size); grid = -1; return; }
        int dev = 0, cus = 0, per_cu = 0;
        if (hipGetDevice(&dev) != hipSuccess || hipDeviceGetAttribute(&cus, hipDeviceAttributeMultiprocessorCount, dev) != hipSuccess) { grid = -1; return; }
        if (hipFuncSetAttribute((const void*)fwd_kernel, hipFuncAttributeMaxDynamicSharedMemorySize, LDS_BYTES) != hipSuccess) { fprintf(stderr, "kernel_launch: hipFuncSetAttribute failed\n"); grid = -1; return; }
        if (hipOccupancyMaxActiveBlocksPerMultiprocessor(&per_cu, (const void*)fwd_kernel, 512, LDS_BYTES) != hipSuccess || per_cu < 1) { fprintf(stderr, "kernel_launch: occupancy query says %d\n", per_cu); }
        (void)hipGetLastError();
        grid = cus;
    }
    if (grid < 0) return;
    (void)hipMemsetAsync((char*)d_ws + WS_CTL, 0, CTL_ZERO_BYTES, stream);
    Args a{};
    for (int i = 0; i < 34; ++i) a.in[i] = (const float*)d_in[i];
    a.out = (float*)d_out; a.ws = (unsigned char*)d_ws;
#if MK_ONE_LAUNCH
    a.ph_lo = 0; a.ph_hi = NPHASE;
    hipLaunchKernelGGL(fwd_kernel, dim3(grid), dim3(512), LDS_BYTES, stream, a);
#else
    for (int k = 0; k < NPHASE; ++k) { a.ph_lo = k; a.ph_hi = k + 1; hipLaunchKernelGGL(fwd_kernel, dim3(grid), dim3(512), LDS_BYTES, stream, a); }
#endif
}
```
